# Optimizing an MI355X kernel written in HIP

```python
import jax, jax.numpy as jnp
from jax import lax
import numpy as np

D_MODEL = 2048
BATCH = 2
SEQ = 4096
DEPTH = 1
DEC_BATCH = 128
DEC_SEQ = 4
PAST_LEN = 2048
PAGE_SIZE = 128

POOL_WINDOWS = (2, 4, 8, 16)
N_POOL_GROUPS = 4
POOL_WIDTH = D_MODEL // 2
POOL_GROUP = POOL_WIDTH // N_POOL_GROUPS
POOL_BUF = max(POOL_WINDOWS) - 1
HEAD_DIM = 128
N_HEADS = D_MODEL // HEAD_DIM
N_KV_HEADS = 4
N_GROUP = N_HEADS // N_KV_HEADS
ATTN_WIDTH = N_HEADS * HEAD_DIM
KV_WIDTH = N_KV_HEADS * HEAD_DIM
N_IDX_HEADS = 16
IDX_DIM = 64
TOPK_MAX = 256
Q_BLOCK = 128
D_FF = -(-8 * D_MODEL // (3 * 256)) * 256
RMS_EPS = 1e-6
IN_SIZES = (POOL_WIDTH, ATTN_WIDTH, KV_WIDTH, KV_WIDTH, N_IDX_HEADS * IDX_DIM, IDX_DIM, N_IDX_HEADS, D_MODEL, D_MODEL)
IN_WIDTH = sum(IN_SIZES)

kernel_name = 'cond_pool_dsa_hybrid_step'


def rmsnorm(x, g):
    xf = x.astype(jnp.float32)
    y = xf * lax.rsqrt(jnp.mean(xf * xf, axis=-1, keepdims=True) + RMS_EPS)
    return (y * g.astype(jnp.float32)).astype(x.dtype)


def modulate(x, g, shift, scale):
    return rmsnorm(x, g) * (1 + scale[:, None]) + shift[:, None]


def adaln(c, w_ada, b_ada):
    mod = jax.nn.silu(c) @ w_ada + b_ada
    return jnp.split(mod, 6, axis=-1)


def split_proj(p):
    outs, o = [], 0
    for s in IN_SIZES:
        outs.append(p[..., o:o + s])
        o += s
    return outs


def pool_mix(seq, start_pos, n_out, w_grp, scale):
    N, R, _ = seq.shape
    cs = jnp.cumsum(jnp.pad(seq.astype(jnp.float32), ((0, 0), (1, 0), (0, 0))), axis=1)
    out_idx = jnp.arange(R - n_out, R)
    pos = start_pos + out_idx
    cur = seq[:, R - n_out:].astype(jnp.float32)
    outs = []
    for g, w in enumerate(POOL_WINDOWS):
        sl = slice(g * POOL_GROUP, (g + 1) * POOL_GROUP)
        cs_g = cs[..., sl]
        lo = jnp.maximum(out_idx + 1 - w, 0)
        win_sum = cs_g[:, out_idx + 1] - cs_g[:, lo]
        cnt = jnp.minimum(pos + 1, w).astype(jnp.float32)
        outs.append(win_sum / cnt[None, :, None] - cur[..., sl])
    d = jnp.stack(outs, axis=2).astype(seq.dtype)
    y = jnp.einsum('ntgc,gce->ntge', d, w_grp).reshape(N, n_out, POOL_WIDTH)
    return y * scale


def indexer_scores(qi, ki, wi):
    dots = jnp.einsum('nthd,nsd->nths', qi, ki, preferred_element_type=jnp.float32) * (IDX_DIM ** -0.5)
    return jnp.einsum('nths,nth->nts', jax.nn.relu(dots), wi.astype(jnp.float32) * (N_IDX_HEADS ** -0.5))


def select_keys(scores, q_pos, topk):
    S = scores.shape[-1]
    vis = jnp.arange(S)[None, :] <= q_pos[:, None]
    masked = jnp.where(vis[None], scores, -jnp.inf)
    _, idx = lax.top_k(masked, topk)
    valid = idx <= q_pos[None, :, None]
    return idx, valid


def sparse_attend(q, k_sel, v_sel, valid):
    N, T = q.shape[:2]
    qg = q.reshape(N, T, N_KV_HEADS, N_GROUP, HEAD_DIM)
    s = jnp.einsum('ntjgd,ntkjd->ntjgk', qg, k_sel, preferred_element_type=jnp.float32) * (HEAD_DIM ** -0.5)
    s = jnp.where(valid[:, :, None, None, :], s, -jnp.inf)
    p = jax.nn.softmax(s, axis=-1).astype(v_sel.dtype)
    o = jnp.einsum('ntjgk,ntkjd->ntjgd', p, v_sel)
    return o.reshape(N, T, ATTN_WIDTH)


def gather_rows(a, i):
    return jax.vmap(lambda ab, ib: ab[ib])(a, i)


def front(x, c, lw):
    mods = adaln(c, lw['w_ada'], lw['b_ada'])
    u = modulate(x, lw['g_norm1'], mods[0], mods[1])
    return mods, split_proj(u @ lw['w_in'])


def back(x, mods, pool_out, attn_out, ga, gb, lw):
    mix = jax.nn.sigmoid(ga) * (pool_out @ lw['w_up_pool']) + jax.nn.sigmoid(gb) * (attn_out @ lw['w_up_attn'])
    h = x + mods[2][:, None] * (mix @ lw['w_out'])
    hn = modulate(h, lw['g_norm2'], mods[3], mods[4])
    gate, up = jnp.split(hn @ lw['w_ffn_in'], 2, axis=-1)
    return h + mods[5][:, None] * ((jax.nn.silu(gate) * up) @ lw['w_ffn_out'])


def layer_prompt(x, c, lw):
    B, T, _ = x.shape
    mods, (pin, q, k, v, qi, ki, wi, ga, gb) = front(x, c, lw)
    seq = jnp.concatenate([jnp.zeros((B, POOL_BUF, POOL_WIDTH), pin.dtype), pin], axis=1)
    pool_out = pool_mix(seq, -POOL_BUF, T, lw['w_pool_grp'], lw['pool_scale'])
    pool_tail = seq[:, -POOL_BUF:]
    q = q.reshape(B, T, N_HEADS, HEAD_DIM)
    k = k.reshape(B, T, N_KV_HEADS, HEAD_DIM)
    v = v.reshape(B, T, N_KV_HEADS, HEAD_DIM)
    qi = qi.reshape(B, T, N_IDX_HEADS, IDX_DIM)
    topk = min(TOPK_MAX, T // 4)
    nb = T // Q_BLOCK

    def blk(args):
        qb, qib, wib, t0 = args
        q_pos = t0 + jnp.arange(Q_BLOCK)
        idx, valid = select_keys(indexer_scores(qib, ki, wib), q_pos, topk)
        return sparse_attend(qb, gather_rows(k, idx), gather_rows(v, idx), valid)

    to_blocks = lambda a: jnp.swapaxes(a.reshape(B, nb, Q_BLOCK, *a.shape[2:]), 0, 1)
    out = lax.map(blk, (to_blocks(q), to_blocks(qi), to_blocks(wi), jnp.arange(nb) * Q_BLOCK))
    attn = jnp.swapaxes(out, 0, 1).reshape(B, T, ATTN_WIDTH)
    y = back(x, mods, pool_out, attn, ga, gb, lw)
    return y, k, v, ki, pool_tail


def layer_sample(x, c, cache_k, cache_v, cache_ik, st_pool, page_table, lw):
    Bn, Tn, _ = x.shape
    page = cache_k.shape[1]
    past = page_table.shape[1] * page
    mods, (pin, q, k, v, qi, ki, wi, ga, gb) = front(x, c, lw)
    seq = jnp.concatenate([st_pool.astype(pin.dtype), pin], axis=1)
    pool_out = pool_mix(seq, past - POOL_BUF, Tn, lw['w_pool_grp'], lw['pool_scale'])
    pool_tail = seq[:, -POOL_BUF:]
    q = q.reshape(Bn, Tn, N_HEADS, HEAD_DIM)
    k = k.reshape(Bn, Tn, N_KV_HEADS, HEAD_DIM)
    v = v.reshape(Bn, Tn, N_KV_HEADS, HEAD_DIM)
    qi = qi.reshape(Bn, Tn, N_IDX_HEADS, IDX_DIM)
    ik_all = jnp.concatenate([cache_ik[page_table].reshape(Bn, past, IDX_DIM).astype(ki.dtype), ki], axis=1)
    topk = min(TOPK_MAX, (past + Tn) // 4)
    q_pos = past + jnp.arange(Tn)
    idx, valid = select_keys(indexer_scores(qi, ik_all, wi), q_pos, topk)
    is_past = (idx < past)[..., None, None]
    ip = jnp.clip(idx, 0, past - 1)
    phys = jax.vmap(lambda pt, i: pt[i])(page_table, ip // page)
    flat = phys * page + ip % page
    inew = jnp.clip(idx - past, 0, Tn - 1)
    k_sel = jnp.where(is_past, cache_k.reshape(-1, N_KV_HEADS, HEAD_DIM)[flat].astype(k.dtype), gather_rows(k, inew))
    v_sel = jnp.where(is_past, cache_v.reshape(-1, N_KV_HEADS, HEAD_DIM)[flat].astype(v.dtype), gather_rows(v, inew))
    attn = sparse_attend(q, k_sel, v_sel, valid)
    y = back(x, mods, pool_out, attn, ga, gb, lw)
    return y, k, v, ki, pool_tail


def setup_inputs(seed: int = 0) -> dict:
    key = jax.random.key(seed)
    ks = jax.random.split(key, 24)
    n_pages = PAST_LEN // PAGE_SIZE
    n_used = DEC_BATCH * n_pages
    n_phys = n_used + n_used // 4
    nrm = lambda k, shape, s=1.0: s * jax.random.normal(k, shape, jnp.float32)
    page_table = jax.random.permutation(ks[0], n_phys)[:n_used].reshape(DEC_BATCH, n_pages).astype(jnp.int32)
    return {
        'x_prompt': nrm(ks[1], (BATCH, SEQ, D_MODEL)),
        'x_sample': nrm(ks[2], (DEC_BATCH, DEC_SEQ, D_MODEL)),
        'cache_k': nrm(ks[3], (DEPTH, n_phys, PAGE_SIZE, N_KV_HEADS, HEAD_DIM)),
        'cache_v': nrm(ks[4], (DEPTH, n_phys, PAGE_SIZE, N_KV_HEADS, HEAD_DIM)),
        'cache_idx_k': nrm(ks[5], (DEPTH, n_phys, PAGE_SIZE, IDX_DIM)),
        'state_pool': nrm(ks[6], (DEPTH, DEC_BATCH, POOL_BUF, POOL_WIDTH)),
        'page_table': page_table,
        'c_prompt': nrm(ks[7], (BATCH, D_MODEL)),
        'c_sample': nrm(ks[8], (DEC_BATCH, D_MODEL)),
        'w_ada': nrm(ks[9], (DEPTH, D_MODEL, 6 * D_MODEL), 0.5 * D_MODEL ** -0.5),
        'b_ada': nrm(ks[10], (DEPTH, 6 * D_MODEL), 0.01),
        'g_norm1': 1.0 + nrm(ks[11], (DEPTH, D_MODEL), 0.1),
        'w_in': nrm(ks[12], (DEPTH, D_MODEL, IN_WIDTH), D_MODEL ** -0.5),
        'w_pool_grp': nrm(ks[13], (DEPTH, N_POOL_GROUPS, POOL_GROUP, POOL_GROUP), POOL_GROUP ** -0.5),
        'pool_scale': 1.0 + nrm(ks[14], (DEPTH, POOL_WIDTH), 0.1),
        'w_up_pool': nrm(ks[15], (DEPTH, POOL_WIDTH, D_MODEL), POOL_WIDTH ** -0.5),
        'w_up_attn': nrm(ks[16], (DEPTH, ATTN_WIDTH, D_MODEL), ATTN_WIDTH ** -0.5),
        'w_out': nrm(ks[17], (DEPTH, D_MODEL, D_MODEL), D_MODEL ** -0.5),
        'g_norm2': 1.0 + nrm(ks[18], (DEPTH, D_MODEL), 0.1),
        'w_ffn_in': nrm(ks[19], (DEPTH, D_MODEL, 2 * D_FF), D_MODEL ** -0.5),
        'w_ffn_out': nrm(ks[20], (DEPTH, D_FF, D_MODEL), D_FF ** -0.5),
        'g_final': 1.0 + nrm(ks[21], (D_MODEL,), 0.1),
    }


def reference(x_prompt, x_sample, cache_k, cache_v, cache_idx_k, state_pool, page_table, c_prompt, c_sample,
              w_ada, b_ada, g_norm1, w_in, w_pool_grp, pool_scale, w_up_pool, w_up_attn, w_out, g_norm2,
              w_ffn_in, w_ffn_out, g_final):
    hp, hs = x_prompt, x_sample
    kp, vp, ip, pp, ksm, vsm, ism, psm = [], [], [], [], [], [], [], []
    for l in range(DEPTH):
        lw = {'w_ada': w_ada[l], 'b_ada': b_ada[l], 'g_norm1': g_norm1[l], 'w_in': w_in[l],
              'w_pool_grp': w_pool_grp[l], 'pool_scale': pool_scale[l], 'w_up_pool': w_up_pool[l],
              'w_up_attn': w_up_attn[l], 'w_out': w_out[l], 'g_norm2': g_norm2[l],
              'w_ffn_in': w_ffn_in[l], 'w_ffn_out': w_ffn_out[l]}
        hp, k1, v1, i1, p1 = layer_prompt(hp, c_prompt, lw)
        hs, k2, v2, i2, p2 = layer_sample(hs, c_sample, cache_k[l], cache_v[l], cache_idx_k[l], state_pool[l], page_table, lw)
        kp.append(k1); vp.append(v1); ip.append(i1); pp.append(p1)
        ksm.append(k2); vsm.append(v2); ism.append(i2); psm.append(p2)
    y_prompt = rmsnorm(hp, g_final)
    y_sample = rmsnorm(hs, g_final)
    k_prompt, v_prompt, idxk_prompt, pool_prompt = jnp.stack(kp), jnp.stack(vp), jnp.stack(ip), jnp.stack(pp)
    k_sample, v_sample, idxk_sample, pool_sample = jnp.stack(ksm), jnp.stack(vsm), jnp.stack(ism), jnp.stack(psm)
    return (y_prompt, y_sample, k_prompt, v_prompt, idxk_prompt, pool_prompt, k_sample, v_sample, idxk_sample, pool_sample)
```

```cpp
#include <hip/hip_runtime.h>
#include <cstdio>
#include <cstdint>

#ifndef MK_MULTI
#define MK_MULTI 1
#endif

namespace pg8 {
#define PG8_LAS __attribute__((address_space(3)))
typedef unsigned short bf16_t;
typedef short bf16x8 __attribute__((ext_vector_type(8)));
typedef float f32x4 __attribute__((ext_vector_type(4)));
typedef unsigned u32x4 __attribute__((ext_vector_type(4)));
typedef unsigned u32x2 __attribute__((ext_vector_type(2)));
constexpr int BM = 256, BK = 64, HALF = 128, HTB = HALF * BK * 2, STAGE_BYTES = 8 * HTB, NXCD = 8, WGM = 8;

__host__ __device__ __forceinline__ int lds_byte(int r, int c) { const int st = (r >> 4) * 2 + (c >> 5), rr = r & 15, cc = c & 31, ob = rr * 64 + cc * 2; return st * 1024 + (ob ^ (((ob >> 9) & 1) << 5)); }
__host__ __device__ __forceinline__ void stage_rc(int b, int& R, int& C) { const int st = b / 1024, sb = b % 1024, swz = sb ^ (((sb >> 9) & 1) << 5); R = (st >> 1) * 16 + swz / 64; C = (st & 1) * 32 + (swz % 64) / 2; }
__host__ __device__ __forceinline__ int perm32(int rho) { const int n = rho >> 4, i = rho & 15; return 8 * (i >> 2) + 4 * n + (i & 3); }

struct Unit { int pm, pn; };
struct Gemm { const bf16_t* A; const bf16_t* Bt; };
template <int K_, int LDA_, int LDB_, size_t APN_> struct Shape { static constexpr int K = K_, LDA = LDA_, LDB = LDB_; static constexpr size_t APN = APN_; };

struct StaticOrder {
    int nM, nN, nwg, G, c;
    __host__ __device__ void init(int M, int N, int G_, int c_) { nM = M / BM; nN = N / BM; nwg = nM * nN; G = G_; c = c_; }
    __host__ __device__ bool next(int i, Unit& u) const {
        const long L = (long)i * G + c; if (L >= nwg) return false;
        int wgid = (int)L; { const int q = nwg / NXCD, r = nwg % NXCD, xcd = wgid % NXCD, off = wgid / NXCD; wgid = (xcd < r ? xcd * (q + 1) : r * (q + 1) + (xcd - r) * q) + off; }
        const int nig = WGM * nN, gid = wgid / nig, fm = gid * WGM, gsz = (nM - fm) < WGM ? (nM - fm) : WGM;
        u.pm = fm + ((wgid % nig) % gsz); u.pn = (wgid % nig) / gsz; return true;
    }
};

__device__ __forceinline__ unsigned cvt_pk_bf16(float lo, float hi) { unsigned r; asm volatile("v_cvt_pk_bf16_f32 %0, %1, %2" : "=v"(r) : "v"(lo), "v"(hi)); return r; }

template <class Epi, class SH, bool ALIGN_EPI = true>
__device__ __forceinline__ void gemm_phase(PG8_LAS unsigned char* lds, const Gemm g, const StaticOrder& S, const Epi& E) {
    const int tid = threadIdx.x, wid = __builtin_amdgcn_readfirstlane(tid >> 6), lane = tid & 63, wr = wid >> 2, wc = wid & 3, fr = lane & 15, fq = lane >> 4;
    constexpr int K = SH::K, nt = K / BK; static_assert(K % 128 == 0 && K >= 256, "K");
    unsigned voffA[2], voffB[2];
#pragma unroll
    for (int i = 0; i < 2; ++i) { int R, C; stage_rc(tid * 16 + i * 8192, R, C); const int Rb = Epi::PERM ? ((R & ~31) + perm32(R & 31)) : R;
        voffA[i] = (unsigned)(R * SH::LDA + C) * 2u; voffB[i] = (unsigned)(Rb * SH::LDB + C) * 2u; }
    constexpr size_t kstep = (size_t)(BK * 2);
    constexpr size_t hA = (size_t)HALF * SH::LDA * 2, hB = (size_t)HALF * SH::LDB * 2;
    constexpr size_t tA = 2 * hA, tB = 2 * hB;
    const unsigned ldsw = (unsigned)wid * 1024u;
    const int aoff = lds_byte(wr * 64 + fr, fq * 8), boff = lds_byte(wc * 32 + fr, fq * 8);
#define PG8_SA(b, h) (((b) * 2 + (h)) * HTB)
#define PG8_SB(b, h) ((4 + (b) * 2 + (h)) * HTB)
#define PG8_STAGE(bufoff, gbase, voff) do { _Pragma("unroll") for (int _i = 0; _i < 2; ++_i) \
        __builtin_amdgcn_global_load_lds((const unsigned*)((const char*)(gbase) + (voff)[_i]), (PG8_LAS unsigned*)(lds + (bufoff) + ldsw + _i * 8192), 16, 0, 0); } while (0)
#define PG8_LDA(dst, b, h) do { _Pragma("unroll") for (int m = 0; m < 4; ++m) _Pragma("unroll") for (int k = 0; k < 2; ++k) dst[m][k] = *(const PG8_LAS bf16x8*)(lds + PG8_SA(b, h) + aoff + m * 2048 + k * 1024); } while (0)
#define PG8_LDB(dst, b, h) do { _Pragma("unroll") for (int n = 0; n < 2; ++n) _Pragma("unroll") for (int k = 0; k < 2; ++k) dst[n][k] = *(const PG8_LAS bf16x8*)(lds + PG8_SB(b, h) + boff + n * 2048 + k * 1024); } while (0)
#define PG8_MMA(ai, bj, At, Bt) do { __builtin_amdgcn_s_setprio(1); _Pragma("unroll") for (int m = 0; m < 4; ++m) _Pragma("unroll") for (int n = 0; n < 2; ++n) _Pragma("unroll") for (int k = 0; k < 2; ++k) \
        acc[ai][bj][m][n] = __builtin_amdgcn_mfma_f32_16x16x32_bf16(Bt[n][k], At[m][k], acc[ai][bj][m][n], 0, 0, 0); __builtin_amdgcn_s_setprio(0); } while (0)
#define PG8_WAIT_V(n) asm volatile("s_waitcnt vmcnt(" #n ")" ::: "memory")
#define PG8_WAIT_L(n) asm volatile("s_waitcnt lgkmcnt(" #n ")" ::: "memory")
#define PG8_BAR __builtin_amdgcn_s_barrier()
#define PG8_SCHED __builtin_amdgcn_sched_barrier(0)
#define PG8_KTILES(T0, T1) do { \
        _Pragma("nounroll") for (int t = (T0); t < (T1); t += 2) { \
            const bool last = (t == nt - 2); \
            const char* a1 = cA + (size_t)(t + 1) * kstep; \
            const char* a2 = last ? nA : cA + (size_t)(t + 2) * kstep; const char* b2 = last ? nB : cB + (size_t)(t + 2) * kstep; \
            const char* a3 = a2 + kstep; const char* b3 = b2 + kstep; \
            PG8_LDB(B0, 0, 0); PG8_LDB(B1, 0, 1); PG8_SCHED; PG8_LDA(At, 0, 0); PG8_STAGE(PG8_SA(1, 1), a1 + hA, voffA); \
            PG8_WAIT_V(8); PG8_WAIT_L(0); PG8_BAR; PG8_MMA(0, 0, At, B0); PG8_MMA(0, 1, At, B1); PG8_BAR; PG8_SCHED; \
            PG8_LDA(At, 0, 1); PG8_STAGE(PG8_SB(0, 0), b2, voffB); PG8_STAGE(PG8_SB(0, 1), b2 + hB, voffB); PG8_STAGE(PG8_SA(0, 0), a2, voffA); \
            PG8_WAIT_V(8); PG8_WAIT_L(0); PG8_BAR; PG8_MMA(1, 0, At, B0); PG8_MMA(1, 1, At, B1); PG8_BAR; PG8_SCHED; \
            PG8_LDB(B0, 1, 0); PG8_LDB(B1, 1, 1); PG8_SCHED; PG8_LDA(At, 1, 0); PG8_STAGE(PG8_SA(0, 1), a2 + hA, voffA); \
            PG8_WAIT_V(8); PG8_WAIT_L(0); PG8_BAR; PG8_MMA(0, 0, At, B0); PG8_MMA(0, 1, At, B1); PG8_BAR; PG8_SCHED; \
            PG8_LDA(At, 1, 1); PG8_STAGE(PG8_SB(1, 0), b3, voffB); PG8_STAGE(PG8_SB(1, 1), b3 + hB, voffB); PG8_STAGE(PG8_SA(1, 0), a3, voffA); \
            PG8_WAIT_V(8); PG8_WAIT_L(0); PG8_BAR; PG8_MMA(1, 0, At, B0); PG8_MMA(1, 1, At, B1); PG8_BAR; PG8_SCHED; \
        } \
    } while (0)
    Unit cur, nxt; int ui = 0;
    if (!S.next(0, cur)) return;
    f32x4 acc[2][2][4][2];
#pragma unroll
    for (int a = 0; a < 2; ++a)
#pragma unroll
        for (int b = 0; b < 2; ++b)
#pragma unroll
            for (int m = 0; m < 4; ++m)
#pragma unroll
                for (int n = 0; n < 2; ++n) acc[a][b][m][n] = (f32x4){0.f, 0.f, 0.f, 0.f};
    bf16x8 At[4][2], B0[2][2], B1[2][2];
    const char* cA = (const char*)g.A + (size_t)cur.pm * tA + (size_t)cur.pn * SH::APN; const char* cB = (const char*)g.Bt + (size_t)cur.pn * tB;
    PG8_STAGE(PG8_SB(0, 0), cB, voffB); PG8_STAGE(PG8_SB(0, 1), cB + hB, voffB); PG8_STAGE(PG8_SA(0, 0), cA, voffA); PG8_STAGE(PG8_SA(0, 1), cA + hA, voffA);
    if (wr == 1) PG8_BAR;
    PG8_WAIT_V(2); PG8_BAR;
    PG8_STAGE(PG8_SB(1, 0), cB + kstep, voffB); PG8_STAGE(PG8_SA(1, 0), cA + kstep, voffA); PG8_STAGE(PG8_SB(1, 1), cB + hB + kstep, voffB);
    PG8_WAIT_V(6); PG8_BAR;
    for (;;) {
        const bool has_next = S.next(ui + 1, nxt);
        const char* nA = has_next ? (const char*)g.A + (size_t)nxt.pm * tA + (size_t)nxt.pn * SH::APN : cA; const char* nB = has_next ? (const char*)g.Bt + (size_t)nxt.pn * tB : cB;
        if constexpr (Epi::HAS_MID) { PG8_KTILES(0, Epi::MID_T); E.mid(acc, cur, wr, wc, fr, fq); PG8_KTILES(Epi::MID_T, nt); } else { PG8_KTILES(0, nt); }
        if constexpr (ALIGN_EPI) { if (wr == 0) PG8_BAR; }
        E(acc, cur, wr, wc, fr, fq);
        if (!has_next) break;
#pragma unroll
        for (int a = 0; a < 2; ++a)
#pragma unroll
            for (int b = 0; b < 2; ++b)
#pragma unroll
                for (int m = 0; m < 4; ++m)
#pragma unroll
                    for (int n = 0; n < 2; ++n) acc[a][b][m][n] = (f32x4){0.f, 0.f, 0.f, 0.f};
        cur = nxt; cA = nA; cB = nB; ++ui;
        if constexpr (ALIGN_EPI) { if (wr == 1) PG8_BAR; }
    }
    PG8_WAIT_V(0);
    if constexpr (!ALIGN_EPI) { if (wr == 0) PG8_BAR; }
    PG8_BAR;
#undef PG8_SA
#undef PG8_SB
#undef PG8_STAGE
#undef PG8_LDA
#undef PG8_LDB
#undef PG8_MMA
#undef PG8_WAIT_V
#undef PG8_WAIT_L
#undef PG8_BAR
#undef PG8_SCHED
#undef PG8_KTILES
}
}

constexpr int D = 2048, SEQ = 4096, NB = 2, TP = NB * SEQ, NSEQ = 128, DSEQ = 4, TS = NSEQ * DSEQ, MR = TP + TS;
constexpr int PAST = 2048, PAGE = 128, NPG = PAST / PAGE, NPHYS = 2560;
constexpr int PW = 1024, PG = 256, PBUF = 15;
constexpr int HD = 128, NH = 16, NKV = 4, AW = 2048, KVW = 512;
constexpr int NIH = 16, IDD = 64, QIW = 1024, TOPK = 256;
constexpr int DFF = 5632, NADA = 6 * D, NCOND = NB + NSEQ;
constexpr int INW = 9296, N1 = 9472;
constexpr float EPS = 1e-6f;
constexpr int SKEYS = PAST + DSEQ, SC_S_LD = 2112;
constexpr unsigned NEWFLAG = 1u << 30;
static_assert(MR % 256 == 0 && N1 % 256 == 0 && DFF % 128 == 0, "tiles");

constexpr size_t OUT_Y = 0, OUT_KP = (size_t)MR * D, OUT_VP = OUT_KP + (size_t)TP * KVW, OUT_IKP = OUT_VP + (size_t)TP * KVW, OUT_PP = OUT_IKP + (size_t)TP * IDD,
                 OUT_KS = OUT_PP + (size_t)NB * PBUF * PW, OUT_VS = OUT_KS + (size_t)TS * KVW, OUT_IKS = OUT_VS + (size_t)TS * KVW, OUT_PS = OUT_IKS + (size_t)TS * IDD,
                 OUT_END = OUT_PS + (size_t)NSEQ * PBUF * PW;
static_assert(OUT_END == 29292544, "output size");

constexpr size_t MiB = 1u << 20;
constexpr size_t al(size_t x) { return (x + MiB - 1) / MiB * MiB; }
constexpr size_t WS_CTL = 0, CTL_ZERO_BYTES = MiB;
constexpr size_t WS_W1T = WS_CTL + MiB;
constexpr size_t WS_WUPT = WS_W1T + al((size_t)N1 * D * 2);
constexpr size_t WS_WOUTT = WS_WUPT + al((size_t)D * 3072 * 2);
constexpr size_t WS_WFIT = WS_WOUTT + al((size_t)D * D * 2);
constexpr size_t WS_WFOT = WS_WFIT + al((size_t)2 * DFF * D * 2);
constexpr size_t WS_WGT = WS_WFOT + al((size_t)D * DFF * 2);
constexpr size_t WS_SC = WS_WGT + al((size_t)PW * PG * 2);
constexpr size_t WS_MODS = WS_SC + al((size_t)144 * D * 2);
constexpr size_t WS_U = WS_MODS + al((size_t)NCOND * NADA * 4);
constexpr size_t WS_PIN = WS_U + al((size_t)MR * D * 2);
constexpr size_t WS_Q = WS_PIN + al((size_t)MR * PW * 4);
constexpr size_t WS_KB = WS_Q + al((size_t)MR * AW * 2);
constexpr size_t WS_VB = WS_KB + al((size_t)MR * KVW * 2);
constexpr size_t WS_QI = WS_VB + al((size_t)MR * KVW * 2);
constexpr size_t WS_KI = WS_QI + al((size_t)MR * QIW * 2);
constexpr size_t WS_WI = WS_KI + al((size_t)MR * IDD * 2);
constexpr size_t WS_GA = WS_WI + al((size_t)MR * NIH * 4);
constexpr size_t WS_GB = WS_GA + al((size_t)MR * D * 2);
constexpr size_t WS_DG = WS_GB + al((size_t)MR * D * 2);
constexpr size_t WS_PA = WS_DG + al((size_t)MR * PW * 2);
constexpr size_t WS_MIX = WS_PA + al((size_t)MR * 3072 * 2);
constexpr size_t WS_H = WS_MIX + al((size_t)MR * D * 2);
constexpr size_t WS_ACT = WS_H + al((size_t)MR * D * 4);
constexpr size_t WS_SCP = WS_ACT + al((size_t)MR * DFF * 2);
constexpr size_t WS_SCS = WS_SCP + al((size_t)TP * SEQ * 4);
constexpr size_t WS_SEL = WS_SCS + al((size_t)TS * SC_S_LD * 4);
constexpr size_t WS_CNT = WS_SEL + al((size_t)MR * TOPK * 4);
constexpr size_t WS_END = WS_CNT + al((size_t)MR * 4);

constexpr int CW_BAR = 4096;
constexpr int NWAVES = 8;
constexpr int LDS_BYTES = 147456;
constexpr int MISC_OFF = 143360;

#define GAS __attribute__((address_space(1)))
#define LAS __attribute__((address_space(3)))
typedef unsigned short bf16;
typedef unsigned v4u __attribute__((ext_vector_type(4)));
typedef unsigned v2u __attribute__((ext_vector_type(2)));
typedef float f32x4 __attribute__((ext_vector_type(4)));
typedef float f32x16 __attribute__((ext_vector_type(16)));
typedef short bf16x8 __attribute__((ext_vector_type(8)));
typedef unsigned short u16x4 __attribute__((ext_vector_type(4)));
#define LDS_WAIT() asm volatile("s_waitcnt lgkmcnt(0)" ::: "memory")
#define VM_WAIT() asm volatile("s_waitcnt vmcnt(0)" ::: "memory")
using pg8::cvt_pk_bf16;
__device__ __forceinline__ float bf2f(unsigned short b) { return __builtin_bit_cast(float, (unsigned)b << 16); }
__device__ __forceinline__ float sigmoidf_(float x) { return __builtin_amdgcn_rcpf(1.0f + __builtin_amdgcn_exp2f(-1.44269504f * x)); }
__device__ __forceinline__ float siluf_(float x) { return x * sigmoidf_(x); }

#define XB_TMO      128
#define XB_XCNT(j)  (256  + 64 * (j))
#define XB_XSUB(j)  (1280 + 64 * (j))
#define XB_XGEN(j)  (2304 + 64 * (j))
#define XB_TOP      3328
#define XB_TOPGEN   3392
#define XCD_BAR_WORDS 3456
#define XB_SPIN_CAP (1u << 18)
__device__ __forceinline__ unsigned xb_ld(unsigned* p)              { return __hip_atomic_load(p, __ATOMIC_RELAXED, __HIP_MEMORY_SCOPE_AGENT); }
__device__ __forceinline__ unsigned xb_add(unsigned* p, unsigned v) { return __hip_atomic_fetch_add(p, v, __ATOMIC_RELAXED, __HIP_MEMORY_SCOPE_AGENT); }
__device__ __forceinline__ unsigned xb_xcc_id() { return (unsigned)__builtin_amdgcn_s_getreg((3 << 11) | 20) & 0xFu; }
#define XB_SPIN(cond, bar) do { unsigned _sp = 0; while (cond) { __builtin_amdgcn_s_sleep(1); \
    if ((++_sp & 255u) == 0u) { if (xb_ld(&(bar)[XB_TMO])) break; if (_sp > XB_SPIN_CAP) { atomicAdd(&(bar)[XB_TMO], 1u); break; } } } } while (0)
struct XcdBarrier { unsigned* bar; unsigned x; volatile LAS unsigned* st; };
__device__ __forceinline__ XcdBarrier xcd_barrier_post(unsigned* bar, volatile LAS unsigned* st) {
    XcdBarrier b; b.bar = bar; b.x = xb_xcc_id(); b.st = st;
    if (threadIdx.x == 0) (void)xb_add(&bar[XB_XCNT(b.x)], 1u);
    return b;
}
__device__ __forceinline__ void xcd_barrier_complete(unsigned* bar, unsigned x, unsigned& nloc, unsigned& nx) {
    const unsigned G = gridDim.x * gridDim.y * gridDim.z;
    unsigned sum, cnt, mine, sp = 0u;
    for (;;) {
        sum = 0u; cnt = 0u; mine = 0u;
#pragma unroll
        for (unsigned j = 0; j < 16; ++j) { const unsigned c = xb_ld(&bar[XB_XCNT(j)]); sum += c; cnt += (c > 0u) ? 1u : 0u; mine = (j == x) ? c : mine; }
        if (sum == G) break;
        __builtin_amdgcn_s_sleep(1);
        if ((++sp & 255u) == 0u) { if (xb_ld(&bar[XB_TMO])) break; if (sp > XB_SPIN_CAP) { atomicAdd(&bar[XB_TMO], 1u); break; } }
    }
    nloc = mine > 0u ? mine : 1u; nx = cnt > 0u ? cnt : 1u;
}
__device__ __forceinline__ void xcd_barrier(const XcdBarrier& b) {
    asm volatile("s_waitcnt vmcnt(0)" ::: "memory");
    __syncthreads();
    if (threadIdx.x == 0) {
        unsigned* bar = b.bar;
        __builtin_amdgcn_s_waitcnt(0);
        unsigned nloc = b.st[0], nx = b.st[1];
        if (nloc == 0u) { xcd_barrier_complete(bar, b.x, nloc, nx); b.st[0] = nloc; b.st[1] = nx; }
        const unsigned old = xb_add(&bar[XB_XSUB(b.x)], 1u);
        const unsigned gen = old / nloc;
        if (old + 1u == (gen + 1u) * nloc) {
            __builtin_amdgcn_fence(__ATOMIC_RELEASE, "agent");
            asm volatile("s_waitcnt vmcnt(0)" ::: "memory");
            const unsigned og = xb_add(&bar[XB_TOP], 1u);
            const unsigned tg = og / nx;
            if (og + 1u == (tg + 1u) * nx) xb_add(&bar[XB_TOPGEN], 1u);
            else XB_SPIN(xb_ld(&bar[XB_TOPGEN]) == tg, bar);
            __builtin_amdgcn_fence(__ATOMIC_ACQUIRE, "agent");
            xb_add(&bar[XB_XGEN(b.x)], 1u);
            asm volatile("s_waitcnt vmcnt(0)" ::: "memory");
        } else {
            XB_SPIN(xb_ld(&bar[XB_XGEN(b.x)]) == gen, bar);
            __builtin_amdgcn_fence(__ATOMIC_ACQUIRE, "agent");
            asm volatile("s_waitcnt vmcnt(0)" ::: "memory");
        }
    }
    __syncthreads();
}

struct Args { const float* in[22]; const int* page_table; float* out; unsigned char* ws; int ph_lo, ph_hi; };
struct Frame {
    LAS unsigned char* lds;
    int tid, lane, wave, vcu, G;
    const float *xp, *xs, *cache_k, *cache_v, *cache_ik, *state_pool, *cp, *cs, *w_ada, *b_ada, *g1, *w_in, *w_grp, *pool_scale, *w_up_pool, *w_up_attn, *w_out, *g2, *w_ffn_in, *w_ffn_out, *g_final;
    const int* page_table;
    float* out; unsigned char* ws;
};
__device__ __forceinline__ int bidx_of(int m) { return m < TP ? (m >> 12) : NB + ((m - TP) >> 2); }
__device__ __forceinline__ const float* xrow_of(const Frame& F, int m) { return m < TP ? F.xp + (size_t)m * D : F.xs + (size_t)(m - TP) * D; }

__device__ __forceinline__ int win_dst_row(int n) { return n < 5120 ? n : (n < 5184 ? 9216 + (n - 5120) : (n < 5200 ? 9280 + (n - 5184) : (n < 7248 ? 5120 + (n - 5200) : 7168 + (n - 7248)))); }
__device__ __forceinline__ int wfi_dst_row(int n) { const int j = n < DFF ? n : n - DFF; return (j >> 7) * 256 + (n < DFF ? 0 : 128) + (j & 127); }
template <int MAP>
__device__ __forceinline__ void p0_transpose_item(const float* W, int K, int N, bf16* WT, int ldt, int coff, int row_off, LAS float* scr, int item, int lane) {
    const int nblk = (N + 31) / 32, kb = item / nblk, nb = item % nblk, k0 = 64 * kb, n0 = 32 * nb;
    const int nl = n0 + (lane & 31);
#pragma unroll 8
    for (int i = 0; i < 32; ++i) { const int kk = 2 * i + (lane >> 5); scr[kk * 33 + (lane & 31)] = nl < N ? W[(size_t)(k0 + kk) * N + nl] : 0.f; }
    LDS_WAIT(); asm volatile("" ::: "memory");
    const int c = lane & 7;
#pragma unroll
    for (int j = 0; j < 4; ++j) { const int n = (lane >> 3) + 8 * j; const LAS float* s = scr + (8 * c) * 33 + n;
        v4u o; o.x = cvt_pk_bf16(s[0 * 33], s[1 * 33]); o.y = cvt_pk_bf16(s[2 * 33], s[3 * 33]); o.z = cvt_pk_bf16(s[4 * 33], s[5 * 33]); o.w = cvt_pk_bf16(s[6 * 33], s[7 * 33]);
        const int ns = n0 + n;
        if (ns < N) { const int dr = MAP == 1 ? win_dst_row(ns) : (MAP == 2 ? wfi_dst_row(ns) : ns);
            *(v4u*)(WT + (size_t)(row_off + dr) * ldt + coff + k0 + 8 * c) = o; } }
    LDS_WAIT(); asm volatile("" ::: "memory");
}
__device__ __forceinline__ void p0_prologue(Frame& F) {
    LAS float* scr = (LAS float*)(F.lds + F.wave * 16384);
    const int gw = F.vcu * NWAVES + F.wave, NGW = F.G * NWAVES;
    bf16* W1T = (bf16*)(F.ws + WS_W1T); bf16* WUPT = (bf16*)(F.ws + WS_WUPT); bf16* WOUTT = (bf16*)(F.ws + WS_WOUTT); bf16* WFIT = (bf16*)(F.ws + WS_WFIT); bf16* WFOT = (bf16*)(F.ws + WS_WFOT); bf16* WGT = (bf16*)(F.ws + WS_WGT);
    constexpr int I_IN = (D / 64) * ((INW + 31) / 32), I_UP = (PW / 64) * (D / 32), I_UA = (AW / 64) * (D / 32), I_OUT = (D / 64) * (D / 32), I_FI = (D / 64) * (2 * DFF / 32), I_FO = (DFF / 64) * (D / 32), I_G1 = (PG / 64) * (PG / 32);
    constexpr int NITEMS = I_IN + I_UP + I_UA + I_OUT + I_FI + I_FO + 4 * I_G1;
    for (int it = gw; it < NITEMS; it += NGW) {
        int r = it;
        if (r < I_IN) { p0_transpose_item<1>(F.w_in, D, INW, W1T, D, 0, 0, scr, r, F.lane); continue; } r -= I_IN;
        if (r < I_UP) { p0_transpose_item<0>(F.w_up_pool, PW, D, WUPT, 3072, 0, 0, scr, r, F.lane); continue; } r -= I_UP;
        if (r < I_UA) { p0_transpose_item<0>(F.w_up_attn, AW, D, WUPT, 3072, PW, 0, scr, r, F.lane); continue; } r -= I_UA;
        if (r < I_OUT) { p0_transpose_item<0>(F.w_out, D, D, WOUTT, D, 0, 0, scr, r, F.lane); continue; } r -= I_OUT;
        if (r < I_FI) { p0_transpose_item<2>(F.w_ffn_in, D, 2 * DFF, WFIT, D, 0, 0, scr, r, F.lane); continue; } r -= I_FI;
        if (r < I_FO) { p0_transpose_item<0>(F.w_ffn_out, DFF, D, WFOT, DFF, 0, 0, scr, r, F.lane); continue; } r -= I_FO;
        { const int g = r / I_G1; p0_transpose_item<0>(F.w_grp + (size_t)g * PG * PG, PG, PG, WGT, PG, 0, g * PG, scr, r % I_G1, F.lane); }
    }
    for (int i = gw * 64 + F.lane; i < 176 * 256; i += NGW * 64) *(v4u*)(W1T + (size_t)INW * D + (size_t)i * 8) = (v4u){0u, 0u, 0u, 0u};
    bf16* SC = (bf16*)(F.ws + WS_SC);
    for (int i = gw * 64 + F.lane; i < 144 * D / 4; i += NGW * 64) { const int row = i / (D / 4), c4 = (i % (D / 4)) * 4;
        f32x4 v = (f32x4){0.f, 0.f, 0.f, 0.f};
        if (row < NB) v = *(const f32x4*)(F.cp + (size_t)row * D + c4); else if (row < NCOND) v = *(const f32x4*)(F.cs + (size_t)(row - NB) * D + c4);
        v2u o; o.x = cvt_pk_bf16(siluf_(v.x), siluf_(v.y)); o.y = cvt_pk_bf16(siluf_(v.z), siluf_(v.w)); *(v2u*)(SC + (size_t)row * D + c4) = o; }
    for (int i = gw * 64 + F.lane; i < NSEQ * 11 * (PW / 4); i += NGW * 64) { const int n = i / (11 * (PW / 4)), rem = i % (11 * (PW / 4)), j = rem / (PW / 4), c4 = (rem % (PW / 4)) * 4;
        *(f32x4*)(F.out + OUT_PS + ((size_t)n * PBUF + j) * PW + c4) = *(const f32x4*)(F.state_pool + ((size_t)n * PBUF + 4 + j) * PW + c4); }
}

__device__ __forceinline__ void p1_adaln(Frame& F) {
    const int gw = F.vcu * NWAVES + F.wave, NGW = F.G * NWAVES, r16 = F.lane & 15, g = F.lane >> 4;
    const bf16* SC = (const bf16*)(F.ws + WS_SC); float* MODS = (float*)(F.ws + WS_MODS);
    for (int ct = gw; ct < NADA / 16; ct += NGW) {
        const int n0 = ct * 16;
        f32x4 acc[9];
#pragma unroll
        for (int rt = 0; rt < 9; ++rt) acc[rt] = (f32x4){0.f, 0.f, 0.f, 0.f};
        const float* wp = F.w_ada + (size_t)(8 * g) * NADA + n0 + r16;
        const bf16* ap = SC + (size_t)r16 * D + 8 * g;
#pragma unroll 2
        for (int ks = 0; ks < D / 32; ++ks) {
            float w[8];
#pragma unroll
            for (int j = 0; j < 8; ++j) w[j] = wp[(size_t)(32 * ks + j) * NADA];
            v4u bw; bw.x = cvt_pk_bf16(w[0], w[1]); bw.y = cvt_pk_bf16(w[2], w[3]); bw.z = cvt_pk_bf16(w[4], w[5]); bw.w = cvt_pk_bf16(w[6], w[7]);
            const bf16x8 bfrag = __builtin_bit_cast(bf16x8, bw);
#pragma unroll
            for (int rt = 0; rt < 9; ++rt) { const bf16x8 af = *(const bf16x8*)(ap + (size_t)(16 * rt) * D + 32 * ks);
                acc[rt] = __builtin_amdgcn_mfma_f32_16x16x32_bf16(af, bfrag, acc[rt], 0, 0, 0); }
        }
        const float bias = F.b_ada[n0 + r16];
#pragma unroll
        for (int rt = 0; rt < 9; ++rt)
#pragma unroll
            for (int i = 0; i < 4; ++i) { const int row = 16 * rt + 4 * g + i; if (row < NCOND) MODS[(size_t)row * NADA + n0 + r16] = acc[rt][i] + bias; }
    }
}

__device__ __forceinline__ float wave_sum(float v) {
#pragma unroll
    for (int o = 1; o < 64; o <<= 1) v += __shfl_xor(v, o);
    return v;
}
__device__ __forceinline__ void modulate_row(const float* xrow, const float* g, const float* shift, const float* scale, bf16* orow, int lane) {
    f32x4 v[8]; float ss = 0.f;
#pragma unroll
    for (int j = 0; j < 8; ++j) { v[j] = *(const f32x4*)(xrow + 4 * lane + 256 * j); ss += (v[j].x * v[j].x + v[j].y * v[j].y) + (v[j].z * v[j].z + v[j].w * v[j].w); }
    const float rstd = 1.0f / sqrtf(wave_sum(ss) * (1.0f / D) + EPS);
#pragma unroll
    for (int j = 0; j < 8; ++j) { const int c = 4 * lane + 256 * j;
        const f32x4 gg = *(const f32x4*)(g + c), sh = *(const f32x4*)(shift + c), sc = *(const f32x4*)(scale + c);
        const f32x4 o = (v[j] * rstd * gg) * (sc + 1.0f) + sh;
        v2u w; w.x = cvt_pk_bf16(o.x, o.y); w.y = cvt_pk_bf16(o.z, o.w); *(v2u*)(orow + c) = w; }
}
__device__ __forceinline__ void final_norm_row(const float* xrow, const float* g, float* orow, int lane) {
    f32x4 v[8]; float ss = 0.f;
#pragma unroll
    for (int j = 0; j < 8; ++j) { v[j] = *(const f32x4*)(xrow + 4 * lane + 256 * j); ss += (v[j].x * v[j].x + v[j].y * v[j].y) + (v[j].z * v[j].z + v[j].w * v[j].w); }
    const float rstd = 1.0f / sqrtf(wave_sum(ss) * (1.0f / D) + EPS);
#pragma unroll
    for (int j = 0; j < 8; ++j) { const int c = 4 * lane + 256 * j; const f32x4 gg = *(const f32x4*)(g + c); *(f32x4*)(orow + c) = v[j] * rstd * gg; }
}

__device__ __forceinline__ void st_bf16x8(bf16* p, const f32x4 a, const f32x4 b) { v4u w; w.x = cvt_pk_bf16(a[0], a[1]); w.y = cvt_pk_bf16(a[2], a[3]); w.z = cvt_pk_bf16(b[0], b[1]); w.w = cvt_pk_bf16(b[2], b[3]); *(v4u*)p = w; }
__device__ __forceinline__ f32x4 sig4(const f32x4 a) { return (f32x4){sigmoidf_(a[0]), sigmoidf_(a[1]), sigmoidf_(a[2]), sigmoidf_(a[3])}; }
__device__ __forceinline__ void ld_bf16x8(const bf16* p, f32x4& a, f32x4& b) { const v4u w = *(const v4u*)p;
    a = (f32x4){__builtin_bit_cast(float, w.x << 16), __builtin_bit_cast(float, w.x & 0xffff0000u), __builtin_bit_cast(float, w.y << 16), __builtin_bit_cast(float, w.y & 0xffff0000u)};
    b = (f32x4){__builtin_bit_cast(float, w.z << 16), __builtin_bit_cast(float, w.z & 0xffff0000u), __builtin_bit_cast(float, w.w << 16), __builtin_bit_cast(float, w.w & 0xffff0000u)}; }

struct EpiIn {
    static constexpr bool PERM = true, HAS_MID = false; int mid_t;
    float* out; float* pin; bf16 *q, *kb, *vb, *qi, *ga, *gb, *ki; float* wi;
    __device__ __forceinline__ void mid(pg8::f32x4 (&)[2][2][4][2], const pg8::Unit&, int, int, int, int) const {}
    __device__ __forceinline__ void operator()(const pg8::f32x4 (&acc)[2][2][4][2], const pg8::Unit& u, int wr, int wc, int fr, int fq) const {
        const int pn = u.pn, row0 = u.pm * 256 + wr * 64 + fr, cl0 = wc * 32 + 8 * fq;
#pragma unroll
        for (int ai = 0; ai < 2; ++ai)
#pragma unroll
            for (int m = 0; m < 4; ++m) { const int r = row0 + ai * 128 + m * 16;
#pragma unroll
                for (int bj = 0; bj < 2; ++bj) { const int cl = cl0 + bj * 128; const f32x4 v0 = acc[ai][bj][m][0], v1 = acc[ai][bj][m][1];
                    if (pn < 4) { const int c = pn * 256 + cl; float* p = pin + (size_t)r * PW + c; *(f32x4*)p = v0; *(f32x4*)(p + 4) = v1;
                        if (r < TP) { const int t = r & (SEQ - 1); if (t >= SEQ - PBUF) { float* o = out + OUT_PP + ((size_t)(r >> 12) * PBUF + (t - (SEQ - PBUF))) * PW + c; *(f32x4*)o = v0; *(f32x4*)(o + 4) = v1; } }
                        else { const int rr = r - TP; float* o = out + OUT_PS + ((size_t)(rr >> 2) * PBUF + 11 + (rr & 3)) * PW + c; *(f32x4*)o = v0; *(f32x4*)(o + 4) = v1; } }
                    else if (pn < 12) { st_bf16x8(q + (size_t)r * AW + (pn - 4) * 256 + cl, v0, v1); }
                    else if (pn < 14) { const int c = (pn - 12) * 256 + cl; st_bf16x8(kb + (size_t)r * KVW + c, v0, v1);
                        float* o = r < TP ? out + OUT_KP + (size_t)r * KVW + c : out + OUT_KS + (size_t)(r - TP) * KVW + c; *(f32x4*)o = v0; *(f32x4*)(o + 4) = v1; }
                    else if (pn < 16) { const int c = (pn - 14) * 256 + cl; st_bf16x8(vb + (size_t)r * KVW + c, v0, v1);
                        float* o = r < TP ? out + OUT_VP + (size_t)r * KVW + c : out + OUT_VS + (size_t)(r - TP) * KVW + c; *(f32x4*)o = v0; *(f32x4*)(o + 4) = v1; }
                    else if (pn < 20) { st_bf16x8(qi + (size_t)r * QIW + (pn - 16) * 256 + cl, v0, v1); }
                    else if (pn < 28) { st_bf16x8(ga + (size_t)r * D + (pn - 20) * 256 + cl, sig4(v0), sig4(v1)); }
                    else if (pn < 36) { st_bf16x8(gb + (size_t)r * D + (pn - 28) * 256 + cl, sig4(v0), sig4(v1)); }
                    else { if (cl < IDD) { st_bf16x8(ki + (size_t)r * IDD + cl, v0, v1);
                               float* o = r < TP ? out + OUT_IKP + (size_t)r * IDD + cl : out + OUT_IKS + (size_t)(r - TP) * IDD + cl; *(f32x4*)o = v0; *(f32x4*)(o + 4) = v1; }
                           else if (cl < IDD + NIH) { float* o = wi + (size_t)r * NIH + (cl - IDD); *(f32x4*)o = v0; *(f32x4*)(o + 4) = v1; } }
                } }
    }
};
struct EpiPool {
    static constexpr bool PERM = true, HAS_MID = false; int mid_t;
    bf16* pa; const float* scale;
    __device__ __forceinline__ void mid(pg8::f32x4 (&)[2][2][4][2], const pg8::Unit&, int, int, int, int) const {}
    __device__ __forceinline__ void operator()(const pg8::f32x4 (&acc)[2][2][4][2], const pg8::Unit& u, int wr, int wc, int fr, int fq) const {
        const int row0 = u.pm * 256 + wr * 64 + fr, c0 = u.pn * 256 + wc * 32 + 8 * fq;
        f32x4 s[2][2];
#pragma unroll
        for (int bj = 0; bj < 2; ++bj) { s[bj][0] = *(const f32x4*)(scale + c0 + bj * 128); s[bj][1] = *(const f32x4*)(scale + c0 + bj * 128 + 4); }
#pragma unroll
        for (int ai = 0; ai < 2; ++ai)
#pragma unroll
            for (int m = 0; m < 4; ++m) { const int r = row0 + ai * 128 + m * 16;
#pragma unroll
                for (int bj = 0; bj < 2; ++bj) st_bf16x8(pa + (size_t)r * 3072 + c0 + bj * 128, acc[ai][bj][m][0] * s[bj][0], acc[ai][bj][m][1] * s[bj][1]); }
    }
};
template <bool SECOND> struct EpiMix {
    static constexpr bool PERM = true, HAS_MID = false; int mid_t;
    const bf16* gate; float* t1; bf16* mix;
    __device__ __forceinline__ void mid(pg8::f32x4 (&)[2][2][4][2], const pg8::Unit&, int, int, int, int) const {}
    __device__ __forceinline__ void operator()(const pg8::f32x4 (&acc)[2][2][4][2], const pg8::Unit& u, int wr, int wc, int fr, int fq) const {
        const int row0 = u.pm * 256 + wr * 64 + fr, c0 = u.pn * 256 + wc * 32 + 8 * fq;
#pragma unroll
        for (int ai = 0; ai < 2; ++ai)
#pragma unroll
            for (int m = 0; m < 4; ++m) { const size_t ro = (size_t)(row0 + ai * 128 + m * 16) * D + c0;
#pragma unroll
                for (int bj = 0; bj < 2; ++bj) { f32x4 b0, b1; ld_bf16x8(gate + ro + bj * 128, b0, b1); float* tp = t1 + ro + bj * 128;
                    if (!SECOND) { *(f32x4*)tp = acc[ai][bj][m][0] * b0; *(f32x4*)(tp + 4) = acc[ai][bj][m][1] * b1; }
                    else { const f32x4 x0 = *(const f32x4*)tp, x1 = *(const f32x4*)(tp + 4); st_bf16x8(mix + ro + bj * 128, x0 + acc[ai][bj][m][0] * b0, x1 + acc[ai][bj][m][1] * b1); } }
                if (m & 1) asm volatile("" ::: "memory"); }
    }
};
struct EpiRes {
    static constexpr bool PERM = false, HAS_MID = false; int mid_t;
    const float *base_p, *base_s; float* o; const float* mods; int moff;
    __device__ __forceinline__ void mid(pg8::f32x4 (&)[2][2][4][2], const pg8::Unit&, int, int, int, int) const {}
    __device__ __forceinline__ void operator()(const pg8::f32x4 (&acc)[2][2][4][2], const pg8::Unit& u, int wr, int wc, int fr, int fq) const {
        const int row0 = u.pm * 256 + wr * 64 + fr, c0 = u.pn * 256 + wc * 32 + 4 * fq;
#pragma unroll
        for (int ai = 0; ai < 2; ++ai)
#pragma unroll
            for (int m = 0; m < 4; ++m) { const int r = row0 + ai * 128 + m * 16;
                const float* bp = (r < TP ? base_p + (size_t)r * D : base_s + (size_t)(r - TP) * D) + c0; const float* mp = mods + (size_t)bidx_of(r) * NADA + moff + c0; float* op = o + (size_t)r * D + c0;
#pragma unroll
                for (int bj = 0; bj < 2; ++bj)
#pragma unroll
                    for (int n = 0; n < 2; ++n) { const int co = bj * 128 + n * 16; *(f32x4*)(op + co) = *(const f32x4*)(bp + co) + *(const f32x4*)(mp + co) * acc[ai][bj][m][n]; }
                if (m & 1) asm volatile("" ::: "memory"); }
    }
};
struct EpiFfn {
    static constexpr bool PERM = true, HAS_MID = false; int mid_t;
    bf16* act;
    __device__ __forceinline__ void mid(pg8::f32x4 (&)[2][2][4][2], const pg8::Unit&, int, int, int, int) const {}
    __device__ __forceinline__ void operator()(const pg8::f32x4 (&acc)[2][2][4][2], const pg8::Unit& u, int wr, int wc, int fr, int fq) const {
        const int row0 = u.pm * 256 + wr * 64 + fr, c0 = u.pn * 128 + wc * 32 + 8 * fq;
#pragma unroll
        for (int ai = 0; ai < 2; ++ai)
#pragma unroll
            for (int m = 0; m < 4; ++m) { const int r = row0 + ai * 128 + m * 16; f32x4 o0, o1;
#pragma unroll
                for (int i = 0; i < 4; ++i) { o0[i] = siluf_(acc[ai][0][m][0][i]) * acc[ai][1][m][0][i]; o1[i] = siluf_(acc[ai][0][m][1][i]) * acc[ai][1][m][1][i]; }
                st_bf16x8(act + (size_t)r * DFF + c0, o0, o1); }
    }
};

__device__ __forceinline__ void p3_pool_d(Frame& F) {
    const int gw = F.vcu * NWAVES + F.wave, NGW = F.G * NWAVES, lane = F.lane;
    const float* PIN = (const float*)(F.ws + WS_PIN); bf16* DG = (bf16*)(F.ws + WS_DG);
    for (int m = gw; m < MR; m += NGW) {
#pragma unroll
        for (int g = 0; g < 4; ++g) { const int w = 2 << g, c = g * PG + 4 * lane;
            f32x4 s = (f32x4){0.f, 0.f, 0.f, 0.f}, cur; float cnt;
            if (m < TP) { const int t = m & (SEQ - 1); cur = *(const f32x4*)(PIN + (size_t)m * PW + c); s = cur; const int nw = t + 1 < w ? t + 1 : w; cnt = (float)nw;
                for (int j = 1; j < nw; ++j) s += *(const f32x4*)(PIN + (size_t)(m - j) * PW + c); }
            else { const int rr = m - TP, n = rr >> 2, tt = rr & 3; cur = *(const f32x4*)(PIN + (size_t)m * PW + c); s = cur; cnt = (float)w;
                for (int j = 1; j < w; ++j) { const int q = PBUF + tt - j;
                    s += q >= PBUF ? *(const f32x4*)(PIN + (size_t)(TP + 4 * n + q - PBUF) * PW + c) : *(const f32x4*)(F.state_pool + ((size_t)n * PBUF + q) * PW + c); } }
            const f32x4 d = s * (1.0f / cnt) - cur;
            v2u o; o.x = cvt_pk_bf16(d.x, d.y); o.y = cvt_pk_bf16(d.z, d.w); *(v2u*)(DG + ((size_t)g * MR + m) * PG + 4 * lane) = o; }
    }
}

constexpr int QS_LD = QIW + 8;
template <bool SAMPLE>
__device__ __forceinline__ void idx_item(Frame& F, int qrow0  , int n  , int kt_lo, int kt_hi) {
    const int lane = F.lane, q = lane & 31, h = lane >> 5;
    const bf16* QI = (const bf16*)(F.ws + WS_QI); const bf16* KI = (const bf16*)(F.ws + WS_KI); const float* WI = (const float*)(F.ws + WS_WI);
    LAS bf16* Qs = (LAS bf16*)F.lds;
    __syncthreads();
#pragma unroll
    for (int i = 0; i < 8; ++i) { const int ch = F.tid + 512 * i, r = ch >> 7, c8 = (ch & 127) * 8; const int rr = SAMPLE ? (r & 3) : r;
        *(LAS v4u*)(Qs + r * QS_LD + c8) = *(const v4u*)(QI + (size_t)(qrow0 + rr) * QIW + c8); }
    LAS float* Ws = (LAS float*)(F.lds + 32 * QS_LD * 2);
    { const int hq = F.tid & 31, hh = F.tid >> 5; Ws[F.tid] = WI[(size_t)(qrow0 + (SAMPLE ? (hq & 3) : hq)) * NIH + hh] * 0.03125f; }
    __syncthreads();
    for (int kt = kt_lo + F.wave; kt < kt_hi; kt += NWAVES) {
        bf16x8 a[4];
        if (!SAMPLE) { const bf16* kp = KI + (size_t)((qrow0 & ~(SEQ - 1)) + kt * 32 + q) * IDD + 8 * h;
#pragma unroll
            for (int ks = 0; ks < 4; ++ks) a[ks] = *(const bf16x8*)(kp + 16 * ks); }
        else { const int s = kt * 32 + q;
            if (s < PAST) { const int pg = F.page_table[n * NPG + (s >> 7)]; const float* kp = F.cache_ik + ((size_t)pg * PAGE + (s & 127)) * IDD + 8 * h;
#pragma unroll
                for (int ks = 0; ks < 4; ++ks) { const f32x4 x0 = *(const f32x4*)(kp + 16 * ks), x1 = *(const f32x4*)(kp + 16 * ks + 4);
                    v4u t; t.x = cvt_pk_bf16(x0.x, x0.y); t.y = cvt_pk_bf16(x0.z, x0.w); t.z = cvt_pk_bf16(x1.x, x1.y); t.w = cvt_pk_bf16(x1.z, x1.w); a[ks] = __builtin_bit_cast(bf16x8, t); } }
            else { const bf16* kp = KI + (size_t)(TP + 4 * n + ((s - PAST) & 3)) * IDD + 8 * h;
#pragma unroll
                for (int ks = 0; ks < 4; ++ks) a[ks] = *(const bf16x8*)(kp + 16 * ks); } }
        f32x16 sc;
#pragma unroll
        for (int i = 0; i < 16; ++i) sc[i] = 0.f;
        const LAS bf16* qb = Qs + q * QS_LD + 8 * h;
#pragma unroll 2
        for (int hd = 0; hd < NIH; ++hd) {
            f32x16 c;
#pragma unroll
            for (int i = 0; i < 16; ++i) c[i] = 0.f;
#pragma unroll
            for (int ks = 0; ks < 4; ++ks) { const bf16x8 b = *(const LAS bf16x8*)(qb + hd * IDD + 16 * ks); c = __builtin_amdgcn_mfma_f32_32x32x16_bf16(a[ks], b, c, 0, 0, 0); }
            const float wh = Ws[hd * 32 + q];
#pragma unroll
            for (int i = 0; i < 16; ++i) sc[i] += fmaxf(c[i], 0.f) * wh;
        }
        if (!SAMPLE) { float* sp = (float*)(F.ws + WS_SCP) + (size_t)(qrow0 + q) * SEQ + kt * 32 + 4 * h;
#pragma unroll
            for (int a4 = 0; a4 < 4; ++a4) *(f32x4*)(sp + 8 * a4) = (f32x4){sc[4 * a4], sc[4 * a4 + 1], sc[4 * a4 + 2], sc[4 * a4 + 3]}; }
        else if (q < DSEQ) { float* sp = (float*)(F.ws + WS_SCS) + (size_t)(4 * n + q) * SC_S_LD + kt * 32 + 4 * h;
#pragma unroll
            for (int a4 = 0; a4 < 4; ++a4) *(f32x4*)(sp + 8 * a4) = (f32x4){sc[4 * a4], sc[4 * a4 + 1], sc[4 * a4 + 2], sc[4 * a4 + 3]}; }
    }
}
__device__ __forceinline__ void p3_indexer(Frame& F) {
    for (int it = F.vcu; it < 256; it += F.G) { const int b = it >> 7, x = it & 127, y = 127 - x;
        idx_item<false>(F, b * SEQ + 32 * x, 0, 0, (x + 2) >> 1);
        idx_item<false>(F, b * SEQ + 32 * y, 0, (y + 2) >> 1, y + 1); }
    for (int it = F.vcu; it < 2 * NSEQ; it += F.G) { const int n = it >> 1, hf = it & 1; idx_item<true>(F, TP + 4 * n, n, hf ? 33 : 0, hf ? 65 : 33); }
    __syncthreads();
}

__device__ __forceinline__ unsigned okey(float f) { const unsigned u = __builtin_bit_cast(unsigned, f); return (u & 0x80000000u) ? ~u : (u | 0x80000000u); }
__device__ __forceinline__ int wave_isum(int v) {
#pragma unroll
    for (int o = 1; o < 64; o <<= 1) v += __shfl_xor(v, o);
    return v;
}
__device__ __forceinline__ void p4_topk(Frame& F) {
    const int gw = F.vcu * NWAVES + F.wave, NGW = F.G * NWAVES, lane = F.lane;
    unsigned* SEL = (unsigned*)(F.ws + WS_SEL); unsigned* CNT = (unsigned*)(F.ws + WS_CNT);
    for (int m = gw; m < MR; m += NGW) {
        const bool smp = m >= TP;
        const int nvalid = smp ? PAST + 1 + ((m - TP) & 3) : (m & (SEQ - 1)) + 1;
        unsigned* sel = SEL + (size_t)m * TOPK;
        if (nvalid <= TOPK) {
#pragma unroll
            for (int j = 0; j < 4; ++j) { const int s = lane + 64 * j; sel[s] = s < nvalid ? (unsigned)s : 0u; }
            if (lane == 0) CNT[m] = (unsigned)nvalid;
            continue;
        }
        const float* sp = smp ? (const float*)(F.ws + WS_SCS) + (size_t)(m - TP) * SC_S_LD : (const float*)(F.ws + WS_SCP) + (size_t)m * SEQ;
        const int nreg = (nvalid + 63) >> 6;
        unsigned key[64];
#pragma unroll
        for (int i = 0; i < 64; ++i) { const int s = i * 64 + lane; key[i] = (i < nreg && s < nvalid) ? okey(sp[s]) : 0u; }
        unsigned tau = 0u; bool exact = false;
        for (int bit = 31; bit >= 0; --bit) {
            const unsigned cand = tau | (1u << bit); int c = 0;
#pragma unroll
            for (int blk = 0; blk < 4; ++blk) if (blk * 16 < nreg) {
#pragma unroll
                for (int i = 0; i < 16; ++i) c += key[blk * 16 + i] >= cand ? 1 : 0; }
            c = wave_isum(c);
            if (c >= TOPK) { tau = cand; if (c == TOPK) { exact = true; break; } }
        }
        int base = 0;
        const int n0 = smp ? (m - TP) >> 2 : 0;
#pragma unroll
        for (int blk = 0; blk < 4; ++blk) if (blk * 16 < nreg) {
#pragma unroll
            for (int i = 0; i < 16; ++i) { const int ii = blk * 16 + i; const bool s_ = exact ? key[ii] >= tau : key[ii] > tau;
                const unsigned long long mk = __ballot(s_); const int pos = base + __builtin_amdgcn_mbcnt_hi((unsigned)(mk >> 32), __builtin_amdgcn_mbcnt_lo((unsigned)mk, 0u));
                if (s_) { const int s = ii * 64 + lane; unsigned e = (unsigned)s;
                    if (smp) e = s < PAST ? (unsigned)F.page_table[n0 * NPG + (s >> 7)] * PAGE + (s & 127) : NEWFLAG + (unsigned)(s - PAST);
                    sel[pos] = e; }
                base += __popcll(mk); } }
        if (!exact) {
#pragma unroll
            for (int blk = 0; blk < 4; ++blk) if (blk * 16 < nreg) {
#pragma unroll
                for (int i = 0; i < 16; ++i) { const int ii = blk * 16 + i; const bool s_ = key[ii] == tau;
                    const unsigned long long mk = __ballot(s_); const int pos = base + __builtin_amdgcn_mbcnt_hi((unsigned)(mk >> 32), __builtin_amdgcn_mbcnt_lo((unsigned)mk, 0u));
                    if (s_ && pos < TOPK) { const int s = ii * 64 + lane; unsigned e = (unsigned)s;
                        if (smp) e = s < PAST ? (unsigned)F.page_table[n0 * NPG + (s >> 7)] * PAGE + (s & 127) : NEWFLAG + (unsigned)(s - PAST);
                        sel[pos] = e; }
                    base += __popcll(mk); } }
        }
        if (lane == 0) CNT[m] = TOPK;
    }
}

constexpr int AT_WAVE_LDS = 9216 + 1024;
__device__ __forceinline__ unsigned off_b(unsigned row, unsigned ch) { return 256u * row + 16u * (ch ^ (((row & 3u) << 2) | ((row >> 2) & 3u))); }
template <bool SAMPLE>
__device__ __forceinline__ void attn_item(Frame& F, int m, int kvh, LAS unsigned char* wl) {
    const int lane = F.lane, r16 = lane & 15, g = lane >> 4;
    const bf16* Q = (const bf16*)(F.ws + WS_Q); const bf16* KB = (const bf16*)(F.ws + WS_KB); const bf16* VB = (const bf16*)(F.ws + WS_VB);
    LAS unsigned* il = (LAS unsigned*)wl; LAS unsigned char* vt = wl + 1024;
    const unsigned cnt = ((const unsigned*)(F.ws + WS_CNT))[m];
    const int nseq = SAMPLE ? (m - TP) >> 2 : 0; const size_t pbase = SAMPLE ? 0 : (size_t)(m & ~(SEQ - 1));
    *(LAS v4u*)(il + 4 * lane) = *(const v4u*)((const unsigned*)(F.ws + WS_SEL) + (size_t)m * TOPK + 4 * lane);
    bf16x8 qf[4];
    { const bf16* qp = Q + (size_t)m * AW + (kvh * 4 + (r16 & 3)) * HD + 8 * g;
#pragma unroll
      for (int ks = 0; ks < 4; ++ks) qf[ks] = *(const bf16x8*)(qp + 32 * ks); }
    LDS_WAIT(); asm volatile("" ::: "memory");
    f32x4 S[16];
#pragma unroll
    for (int kt = 0; kt < 16; ++kt) {
        const unsigned e = il[kt * 16 + r16];
        bf16x8 a[4];
        if (!SAMPLE) { const bf16* kp = KB + (pbase + e) * KVW + kvh * HD + 8 * g;
#pragma unroll
            for (int ks = 0; ks < 4; ++ks) a[ks] = *(const bf16x8*)(kp + 32 * ks); }
        else if (e < NEWFLAG) { const float* kp = F.cache_k + ((size_t)e * NKV + kvh) * HD + 8 * g;
#pragma unroll
            for (int ks = 0; ks < 4; ++ks) { const f32x4 x0 = *(const f32x4*)(kp + 32 * ks), x1 = *(const f32x4*)(kp + 32 * ks + 4);
                v4u t; t.x = cvt_pk_bf16(x0.x, x0.y); t.y = cvt_pk_bf16(x0.z, x0.w); t.z = cvt_pk_bf16(x1.x, x1.y); t.w = cvt_pk_bf16(x1.z, x1.w); a[ks] = __builtin_bit_cast(bf16x8, t); } }
        else { const bf16* kp = KB + (size_t)(TP + 4 * nseq + (e & 3u)) * KVW + kvh * HD + 8 * g;
#pragma unroll
            for (int ks = 0; ks < 4; ++ks) a[ks] = *(const bf16x8*)(kp + 32 * ks); }
        f32x4 c = (f32x4){0.f, 0.f, 0.f, 0.f};
#pragma unroll
        for (int ks = 0; ks < 4; ++ks) c = __builtin_amdgcn_mfma_f32_16x16x32_bf16(a[ks], qf[ks], c, 0, 0, 0);
        S[kt] = c;
    }
    constexpr float SCL = 0.08838834764831845f * 1.4426950408889634f;
    float mx = -INFINITY;
#pragma unroll
    for (int kt = 0; kt < 16; ++kt)
#pragma unroll
        for (int i = 0; i < 4; ++i) { const unsigned slot = kt * 16 + 4 * g + i; const float s = slot < cnt ? S[kt][i] * SCL : -INFINITY; S[kt][i] = s; mx = fmaxf(mx, s); }
    mx = fmaxf(mx, __shfl_xor(mx, 16)); mx = fmaxf(mx, __shfl_xor(mx, 32));
    float sum = 0.f;
#pragma unroll
    for (int kt = 0; kt < 16; ++kt)
#pragma unroll
        for (int i = 0; i < 4; ++i) { const float p = __builtin_amdgcn_exp2f(S[kt][i] - mx); S[kt][i] = p; sum += p; }
    sum += __shfl_xor(sum, 16); sum += __shfl_xor(sum, 32);
    f32x4 O[8];
#pragma unroll
    for (int c = 0; c < 8; ++c) O[c] = (f32x4){0.f, 0.f, 0.f, 0.f};
    const unsigned q4 = (lane & 15) >> 2, p4 = lane & 3;
    const unsigned xh = (q4 << 1) | (g & 1);
    const unsigned trb0 = 2048u * g + 256u * q4 + 16u * (p4 >> 1) + 8u * (p4 & 1);
    const unsigned trb1 = 2048u * g + 1024u + 256u * q4 + 16u * ((p4 >> 1) ^ 1u) + 8u * (p4 & 1);
    const unsigned vtb = (unsigned)(size_t)vt;
#pragma unroll
    for (int ks = 0; ks < 8; ++ks) {
        v4u vv[8];
#pragma unroll
        for (int i = 0; i < 8; ++i) { const unsigned e = il[(2 * ks + (i & 1)) * 16 + 4 * (i >> 1) + g];
            if (!SAMPLE) vv[i] = *(const v4u*)(VB + (pbase + e) * KVW + kvh * HD + 8 * r16);
            else if (e < NEWFLAG) { const float* vp = F.cache_v + ((size_t)e * NKV + kvh) * HD + 8 * r16; const f32x4 x0 = *(const f32x4*)vp, x1 = *(const f32x4*)(vp + 4);
                vv[i].x = cvt_pk_bf16(x0.x, x0.y); vv[i].y = cvt_pk_bf16(x0.z, x0.w); vv[i].z = cvt_pk_bf16(x1.x, x1.y); vv[i].w = cvt_pk_bf16(x1.z, x1.w); }
            else vv[i] = *(const v4u*)(VB + (size_t)(TP + 4 * nseq + (e & 3u)) * KVW + kvh * HD + 8 * r16); }
        LDS_WAIT(); asm volatile("" ::: "memory");
#pragma unroll
        for (int i = 0; i < 8; ++i) *(LAS v4u*)(vt + off_b((unsigned)(g + 4 * i), (unsigned)r16)) = vv[i];
        LDS_WAIT(); asm volatile("" ::: "memory");
        v4u pw; pw.x = cvt_pk_bf16(S[2 * ks][0], S[2 * ks][1]); pw.y = cvt_pk_bf16(S[2 * ks][2], S[2 * ks][3]); pw.z = cvt_pk_bf16(S[2 * ks + 1][0], S[2 * ks + 1][1]); pw.w = cvt_pk_bf16(S[2 * ks + 1][2], S[2 * ks + 1][3]);
        const bf16x8 pf = __builtin_bit_cast(bf16x8, pw);
#pragma unroll
        for (int c4 = 0; c4 < 2; ++c4) {
            v2u b0[4], b1[4];
            const unsigned a0 = vtb + trb0 + 32u * ((4u * c4 + 0u) ^ xh), a1 = vtb + trb0 + 32u * ((4u * c4 + 1u) ^ xh), a2 = vtb + trb0 + 32u * ((4u * c4 + 2u) ^ xh), a3 = vtb + trb0 + 32u * ((4u * c4 + 3u) ^ xh);
            const unsigned d0 = vtb + trb1 + 32u * ((4u * c4 + 0u) ^ xh), d1 = vtb + trb1 + 32u * ((4u * c4 + 1u) ^ xh), d2 = vtb + trb1 + 32u * ((4u * c4 + 2u) ^ xh), d3 = vtb + trb1 + 32u * ((4u * c4 + 3u) ^ xh);
            asm volatile("ds_read_b64_tr_b16 %0, %8\n\tds_read_b64_tr_b16 %1, %9\n\tds_read_b64_tr_b16 %2, %10\n\tds_read_b64_tr_b16 %3, %11\n\t"
                         "ds_read_b64_tr_b16 %4, %12\n\tds_read_b64_tr_b16 %5, %13\n\tds_read_b64_tr_b16 %6, %14\n\tds_read_b64_tr_b16 %7, %15\n\ts_waitcnt lgkmcnt(0)"
                         : "=&v"(b0[0]), "=&v"(b0[1]), "=&v"(b0[2]), "=&v"(b0[3]), "=&v"(b1[0]), "=&v"(b1[1]), "=&v"(b1[2]), "=&v"(b1[3])
                         : "v"(a0), "v"(a1), "v"(a2), "v"(a3), "v"(d0), "v"(d1), "v"(d2), "v"(d3) : "memory");
#pragma unroll
            for (int cc = 0; cc < 4; ++cc) { v4u bw; bw.x = b0[cc].x; bw.y = b0[cc].y; bw.z = b1[cc].x; bw.w = b1[cc].y;
                O[4 * c4 + cc] = __builtin_amdgcn_mfma_f32_16x16x32_bf16(pf, __builtin_bit_cast(bf16x8, bw), O[4 * c4 + cc], 0, 0, 0); }
        }
    }
    float inv[4];
#pragma unroll
    for (int i = 0; i < 4; ++i) inv[i] = 1.0f / __shfl(sum, i);
    if (g == 0) { bf16* op = (bf16*)(F.ws + WS_PA) + (size_t)m * 3072 + PW + (kvh * 4) * HD + r16;
#pragma unroll
        for (int c = 0; c < 8; ++c)
#pragma unroll
            for (int i = 0; i < 4; ++i) op[i * HD + 16 * c] = (bf16)(cvt_pk_bf16(O[c][i] * inv[i], 0.f) & 0xffffu); }
    LDS_WAIT(); asm volatile("" ::: "memory");
}
__device__ __forceinline__ void p5_attention(Frame& F) {
    const int gw = F.vcu * NWAVES + F.wave, NGW = F.G * NWAVES;
    LAS unsigned char* wl = F.lds + F.wave * AT_WAVE_LDS;
    const int per = (NB * NKV * SEQ + NGW - 1) / NGW;
    for (int k = 0; k < per; ++k) { const int idx = gw * per + k; if (idx >= NB * NKV * SEQ) break;
        const int x = idx >> 12, t = idx & (SEQ - 1); attn_item<false>(F, (x >> 2) * SEQ + t, x & 3, wl); }
    for (int idx = gw; idx < TS * NKV; idx += NGW) attn_item<true>(F, TP + (idx >> 2), idx & 3, wl);
}

constexpr int NPHASE = 13;
__global__ void __launch_bounds__(NWAVES * 64, 2) fwd(Args args) {
    extern __shared__ __attribute__((aligned(16))) unsigned char lds[];
    Frame F;
    F.lds = (LAS unsigned char*)lds;
    F.tid = threadIdx.x; F.lane = F.tid & 63; F.wave = __builtin_amdgcn_readfirstlane(F.tid >> 6);
    F.G = gridDim.x; { const int bx = blockIdx.x; F.vcu = (F.G % 8 == 0) ? (bx % 8) * (F.G / 8) + bx / 8 : bx; }
    F.xp = args.in[0]; F.xs = args.in[1]; F.cache_k = args.in[2]; F.cache_v = args.in[3]; F.cache_ik = args.in[4]; F.state_pool = args.in[5];
    F.cp = args.in[7]; F.cs = args.in[8]; F.w_ada = args.in[9]; F.b_ada = args.in[10]; F.g1 = args.in[11]; F.w_in = args.in[12]; F.w_grp = args.in[13]; F.pool_scale = args.in[14];
    F.w_up_pool = args.in[15]; F.w_up_attn = args.in[16]; F.w_out = args.in[17]; F.g2 = args.in[18]; F.w_ffn_in = args.in[19]; F.w_ffn_out = args.in[20]; F.g_final = args.in[21];
    F.page_table = args.page_table; F.out = args.out; F.ws = args.ws;
    volatile LAS unsigned* MISC = (volatile LAS unsigned*)(F.lds + MISC_OFF);
    for (int u = F.tid; u < (LDS_BYTES - MISC_OFF) / 4; u += NWAVES * 64) MISC[u] = 0u;
    __syncthreads();
    unsigned* ctl = (unsigned*)(F.ws + WS_CTL);
    XcdBarrier bar; bar.bar = ctl + CW_BAR; bar.x = 0; bar.st = nullptr;
    if (!MK_MULTI) bar = xcd_barrier_post(ctl + CW_BAR, MISC + 8);
    const int lo = args.ph_lo, hi = args.ph_hi;
#ifndef PH_MASK
#define PH_MASK 0x1fff
#endif
#define IN(k) (((PH_MASK >> (k)) & 1) && lo <= (k) && (k) < hi)
#define SEAM(k) do { if (IN(k) && IN((k) + 1)) xcd_barrier(bar); } while (0)
    const int gw = F.vcu * NWAVES + F.wave, NGW = F.G * NWAVES;
    float* MODS = (float*)(F.ws + WS_MODS); bf16* U = (bf16*)(F.ws + WS_U); float* H = (float*)(F.ws + WS_H);

    if (IN(0)) { p0_prologue(F); } SEAM(0);
    if (IN(1)) { p1_adaln(F); } SEAM(1);
    if (IN(2)) {
        for (int m = gw; m < MR; m += NGW) { const float* md = MODS + (size_t)bidx_of(m) * NADA; modulate_row(xrow_of(F, m), F.g1, md, md + D, U + (size_t)m * D, F.lane); }
    } SEAM(2);
    if (IN(3)) {
        pg8::Gemm g{U, (const bf16*)(F.ws + WS_W1T)}; pg8::StaticOrder S; S.init(MR, N1, F.G, (int)blockIdx.x);
        EpiIn E{0, F.out, (float*)(F.ws + WS_PIN), (bf16*)(F.ws + WS_Q), (bf16*)(F.ws + WS_KB), (bf16*)(F.ws + WS_VB), (bf16*)(F.ws + WS_QI), (bf16*)(F.ws + WS_GA), (bf16*)(F.ws + WS_GB), (bf16*)(F.ws + WS_KI), (float*)(F.ws + WS_WI)};
        pg8::gemm_phase<EpiIn, pg8::Shape<D, D, D, 0>>(F.lds, g, S, E);
    } SEAM(3);
    if (IN(4)) { p3_pool_d(F); p3_indexer(F); } SEAM(4);
    if (IN(5)) {
        pg8::Gemm g{(const bf16*)(F.ws + WS_DG), (const bf16*)(F.ws + WS_WGT)}; pg8::StaticOrder S; S.init(MR, PW, F.G, (int)blockIdx.x);
        EpiPool E{0, (bf16*)(F.ws + WS_PA), F.pool_scale};
        pg8::gemm_phase<EpiPool, pg8::Shape<PG, PG, PG, (size_t)MR * PG * 2>>(F.lds, g, S, E);
        p4_topk(F);
    } SEAM(5);
    if (IN(6)) { p5_attention(F); } SEAM(6);
    if (IN(7)) {
        pg8::StaticOrder S; S.init(MR, D, F.G, (int)blockIdx.x);
        { pg8::Gemm g{(const bf16*)(F.ws + WS_PA), (const bf16*)(F.ws + WS_WUPT)};
          EpiMix<false> E{0, (const bf16*)(F.ws + WS_GA), H, (bf16*)(F.ws + WS_MIX)};
          pg8::gemm_phase<EpiMix<false>, pg8::Shape<PW, 3072, 3072, 0>>(F.lds, g, S, E); }
        { pg8::Gemm g{(const bf16*)(F.ws + WS_PA) + PW, (const bf16*)(F.ws + WS_WUPT) + PW};
          EpiMix<true> E{0, (const bf16*)(F.ws + WS_GB), H, (bf16*)(F.ws + WS_MIX)};
          pg8::gemm_phase<EpiMix<true>, pg8::Shape<AW, 3072, 3072, 0>>(F.lds, g, S, E); }
    } SEAM(7);
    if (IN(8)) {
        pg8::Gemm g{(const bf16*)(F.ws + WS_MIX), (const bf16*)(F.ws + WS_WOUTT)}; pg8::StaticOrder S; S.init(MR, D, F.G, (int)blockIdx.x);
        EpiRes E{0, F.xp, F.xs, H, MODS, 2 * D};
        pg8::gemm_phase<EpiRes, pg8::Shape<D, D, D, 0>>(F.lds, g, S, E);
    } SEAM(8);
    if (IN(9)) {
        for (int m = gw; m < MR; m += NGW) { const float* md = MODS + (size_t)bidx_of(m) * NADA; modulate_row(H + (size_t)m * D, F.g2, md + 3 * D, md + 4 * D, U + (size_t)m * D, F.lane); }
    } SEAM(9);
    if (IN(10)) {
        pg8::Gemm g{U, (const bf16*)(F.ws + WS_WFIT)}; pg8::StaticOrder S; S.init(MR, 2 * DFF, F.G, (int)blockIdx.x);
        EpiFfn E{0, (bf16*)(F.ws + WS_ACT)};
        pg8::gemm_phase<EpiFfn, pg8::Shape<D, D, D, 0>>(F.lds, g, S, E);
    } SEAM(10);
    if (IN(11)) {
        pg8::Gemm g{(const bf16*)(F.ws + WS_ACT), (const bf16*)(F.ws + WS_WFOT)}; pg8::StaticOrder S; S.init(MR, D, F.G, (int)blockIdx.x);
        EpiRes E{0, H, H + (size_t)TP * D, H, MODS, 5 * D};
        pg8::gemm_phase<EpiRes, pg8::Shape<DFF, DFF, DFF, 0>>(F.lds, g, S, E);
    } SEAM(11);
    if (IN(12)) {
        for (int m = gw; m < MR; m += NGW) final_norm_row(H + (size_t)m * D, F.g_final, F.out + OUT_Y + (size_t)m * D, F.lane);
    }
#undef IN
#undef SEAM
}

extern "C" void kernel_launch(void* const* d_in, const int* in_sizes, int n_in, void* d_out, int out_size, void* d_ws, size_t ws_size, hipStream_t stream) {
    static int grid = 0;
    if (grid == 0) {
        if (n_in != 22 || (size_t)out_size != OUT_END || ws_size < WS_END) { fprintf(stderr, "kernel_launch: unexpected shapes (n_in %d, out %d, ws %zu, need %zu)\n", n_in, out_size, ws_size, (size_t)WS_END); grid = -1; return; }
        int dev = 0, cus = 0, per_cu = 0;
        if (hipGetDevice(&dev) != hipSuccess || hipDeviceGetAttribute(&cus, hipDeviceAttributeMultiprocessorCount, dev) != hipSuccess) { grid = -1; return; }
        if (hipFuncSetAttribute((const void*)fwd, hipFuncAttributeMaxDynamicSharedMemorySize, LDS_BYTES) != hipSuccess) { fprintf(stderr, "kernel_launch: hipFuncSetAttribute failed\n"); grid = -1; return; }
        if (hipOccupancyMaxActiveBlocksPerMultiprocessor(&per_cu, (const void*)fwd, NWAVES * 64, LDS_BYTES) != hipSuccess || per_cu < 1) fprintf(stderr, "kernel_launch: occupancy query says %d\n", per_cu);
        (void)hipGetLastError();
        grid = cus;
    }
    if (grid < 0) return;
    (void)hipMemsetAsync((char*)d_ws + WS_CTL, 0, CTL_ZERO_BYTES, stream);
    Args a{};
    for (int i = 0; i < 22; ++i) a.in[i] = (const float*)d_in[i];
    a.page_table = (const int*)d_in[6]; a.out = (float*)d_out; a.ws = (unsigned char*)d_ws;
#if MK_MULTI
    for (int p = 0; p < NPHASE; ++p) { a.ph_lo = p; a.ph_hi = p + 1; hipLaunchKernelGGL(fwd, dim3(grid), dim3(NWAVES * 64), LDS_BYTES, stream, a); }
#else
    a.ph_lo = 0; a.ph_hi = NPHASE; hipLaunchKernelGGL(fwd, dim3(grid), dim3(NWAVES * 64), LDS_BYTES, stream, a);
#endif
    const hipError_t le = hipPeekAtLastError();
    if (le != hipSuccess) fprintf(stderr, "kernel_launch: launch failed: %s\n", hipGetErrorName(le));
}
```

```cpp
#include <hip/hip_runtime.h>
#include <cstdio>
#include <cstdint>

#ifndef PROBE_STREAM_REPS
#define PROBE_STREAM_REPS 1
#endif
#ifndef MK_MULTI
#define MK_MULTI 0
#endif

namespace pg8 {
#define PG8_LAS __attribute__((address_space(3)))
typedef unsigned short bf16_t;
typedef short bf16x8 __attribute__((ext_vector_type(8)));
typedef float f32x4 __attribute__((ext_vector_type(4)));
typedef unsigned u32x4 __attribute__((ext_vector_type(4)));
typedef unsigned u32x2 __attribute__((ext_vector_type(2)));
constexpr int BM = 256, BK = 64, HALF = 128, HTB = HALF * BK * 2, STAGE_BYTES = 8 * HTB, NXCD = 8, WGM = 8;

__host__ __device__ __forceinline__ int lds_byte(int r, int c) { const int st = (r >> 4) * 2 + (c >> 5), rr = r & 15, cc = c & 31, ob = rr * 64 + cc * 2; return st * 1024 + (ob ^ (((ob >> 9) & 1) << 5)); }
__host__ __device__ __forceinline__ void stage_rc(int b, int& R, int& C) { const int st = b / 1024, sb = b % 1024, swz = sb ^ (((sb >> 9) & 1) << 5); R = (st >> 1) * 16 + swz / 64; C = (st & 1) * 32 + (swz % 64) / 2; }
__host__ __device__ __forceinline__ int perm32(int rho) { const int n = rho >> 4, i = rho & 15; return 8 * (i >> 2) + 4 * n + (i & 3); }

struct Unit { int pm, pn, ks; };
struct Gemm { const bf16_t* A; const bf16_t* Bt; };
template <int K_, int LDA_, int LDB_, size_t APN_> struct Shape { static constexpr int K = K_, LDA = LDA_, LDB = LDB_; static constexpr size_t APN = APN_; };
struct SplitOrder {
    int pm0, npm, nN, nks, G, c;
    __host__ __device__ bool next(int i, Unit& u) const { const int L = i * G + c; if (L >= npm * nN * nks) return false; u.pm = pm0 + L % npm; u.pn = (L / npm) % nN; u.ks = L / (npm * nN); return true; }
};

struct StaticOrder {
    int nM, nN, nwg, G, c;
    __host__ __device__ void init(int M, int N, int G_, int c_) { nM = M / BM; nN = N / BM; nwg = nM * nN; G = G_; c = c_; }
    __host__ __device__ bool next(int i, Unit& u) const {
        const long L = (long)i * G + c; if (L >= nwg) return false;
        int wgid = (int)L; { const int q = nwg / NXCD, r = nwg % NXCD, xcd = wgid % NXCD, off = wgid / NXCD; wgid = (xcd < r ? xcd * (q + 1) : r * (q + 1) + (xcd - r) * q) + off; }
        const int nig = WGM * nN, gid = wgid / nig, fm = gid * WGM, gsz = (nM - fm) < WGM ? (nM - fm) : WGM;
        u.pm = fm + ((wgid % nig) % gsz); u.pn = (wgid % nig) / gsz; u.ks = 0; return true;
    }
};

typedef __bf16 bf16x2_n __attribute__((ext_vector_type(2)));
typedef float f32x2_n __attribute__((ext_vector_type(2)));
__device__ __forceinline__ unsigned cvt_pk_bf16(float lo, float hi) { const f32x2_n v = {lo, hi}; return __builtin_bit_cast(unsigned, __builtin_convertvector(v, bf16x2_n)); }

template <class Epi, class SH, class Sched = StaticOrder, bool ALIGN_EPI = true>
__device__ __forceinline__ void gemm_phase(PG8_LAS unsigned char* lds, const Gemm g, const Sched& S, const Epi& E, const int wid, const int lane) {
    const int tid = wid * 64 + lane, wr = wid >> 2, wc = wid & 3, fr = lane & 15, fq = lane >> 4;
    constexpr int K = SH::K, nt = K / BK; static_assert(K % 128 == 0 && K >= 256, "K");
    unsigned voffA[2], voffB[2];
#pragma unroll
    for (int i = 0; i < 2; ++i) { int R, C; stage_rc(tid * 16 + i * 8192, R, C); const int Rb = Epi::PERM ? ((R & ~31) + perm32(R & 31)) : R;
        voffA[i] = (unsigned)(R * SH::LDA + C) * 2u; voffB[i] = (unsigned)(Rb * SH::LDB + C) * 2u; }
    constexpr size_t kstep = (size_t)(BK * 2);
    constexpr size_t hA = (size_t)HALF * SH::LDA * 2, hB = (size_t)HALF * SH::LDB * 2;
    constexpr size_t tA = 2 * hA, tB = 2 * hB;
    const unsigned ldsw = (unsigned)wid * 1024u;
    const int aoff = lds_byte(wr * 64 + fr, fq * 8), boff = lds_byte(wc * 32 + fr, fq * 8);
#define PG8_SA(b, h) (((b) * 2 + (h)) * HTB)
#define PG8_SB(b, h) ((4 + (b) * 2 + (h)) * HTB)
#define PG8_STAGE(bufoff, gbase, voff) do { _Pragma("unroll") for (int _i = 0; _i < 2; ++_i) \
        __builtin_amdgcn_global_load_lds((const unsigned*)((const char*)(gbase) + (voff)[_i]), (PG8_LAS unsigned*)(lds + (bufoff) + ldsw + _i * 8192), 16, 0, 0); } while (0)
#define PG8_LDA(dst, b, h) do { _Pragma("unroll") for (int m = 0; m < 4; ++m) _Pragma("unroll") for (int k = 0; k < 2; ++k) dst[m][k] = *(const PG8_LAS bf16x8*)(lds + PG8_SA(b, h) + aoff + m * 2048 + k * 1024); } while (0)
#define PG8_LDB(dst, b, h) do { _Pragma("unroll") for (int n = 0; n < 2; ++n) _Pragma("unroll") for (int k = 0; k < 2; ++k) dst[n][k] = *(const PG8_LAS bf16x8*)(lds + PG8_SB(b, h) + boff + n * 2048 + k * 1024); } while (0)
#define PG8_MMA(ai, bj, At, Bt) do { __builtin_amdgcn_s_setprio(1); _Pragma("unroll") for (int m = 0; m < 4; ++m) _Pragma("unroll") for (int n = 0; n < 2; ++n) _Pragma("unroll") for (int k = 0; k < 2; ++k) \
        acc[ai][bj][m][n] = __builtin_amdgcn_mfma_f32_16x16x32_bf16(Bt[n][k], At[m][k], acc[ai][bj][m][n], 0, 0, 0); __builtin_amdgcn_s_setprio(0); } while (0)
#define PG8_WAIT_V(n) asm volatile("s_waitcnt vmcnt(" #n ")" ::: "memory")
#define PG8_WAIT_L(n) asm volatile("s_waitcnt lgkmcnt(" #n ")" ::: "memory")
#define PG8_BAR __builtin_amdgcn_s_barrier()
#define PG8_SCHED __builtin_amdgcn_sched_barrier(0)
#define PG8_KTILES(T0, T1) do { \
        _Pragma("nounroll") for (int t = (T0); t < (T1); t += 2) { \
            const bool last = (t == nt - 2); \
            const char* a1 = cA + (size_t)(t + 1) * kstep; \
            const char* a2 = last ? nA : cA + (size_t)(t + 2) * kstep; const char* b2 = last ? nB : cB + (size_t)(t + 2) * kstep; \
            const char* a3 = a2 + kstep; const char* b3 = b2 + kstep; \
            PG8_LDB(B0, 0, 0); PG8_LDB(B1, 0, 1); PG8_SCHED; PG8_LDA(At, 0, 0); PG8_STAGE(PG8_SA(1, 1), a1 + hA, voffA); \
            PG8_WAIT_V(8); PG8_WAIT_L(0); PG8_BAR; PG8_MMA(0, 0, At, B0); PG8_MMA(0, 1, At, B1); PG8_BAR; PG8_SCHED; \
            PG8_LDA(At, 0, 1); PG8_STAGE(PG8_SB(0, 0), b2, voffB); PG8_STAGE(PG8_SB(0, 1), b2 + hB, voffB); PG8_STAGE(PG8_SA(0, 0), a2, voffA); \
            PG8_WAIT_V(8); PG8_WAIT_L(0); PG8_BAR; PG8_MMA(1, 0, At, B0); PG8_MMA(1, 1, At, B1); PG8_BAR; PG8_SCHED; \
            PG8_LDB(B0, 1, 0); PG8_LDB(B1, 1, 1); PG8_SCHED; PG8_LDA(At, 1, 0); PG8_STAGE(PG8_SA(0, 1), a2 + hA, voffA); \
            PG8_WAIT_V(8); PG8_WAIT_L(0); PG8_BAR; PG8_MMA(0, 0, At, B0); PG8_MMA(0, 1, At, B1); PG8_BAR; PG8_SCHED; \
            PG8_LDA(At, 1, 1); PG8_STAGE(PG8_SB(1, 0), b3, voffB); PG8_STAGE(PG8_SB(1, 1), b3 + hB, voffB); PG8_STAGE(PG8_SA(1, 0), a3, voffA); \
            PG8_WAIT_V(8); PG8_WAIT_L(0); PG8_BAR; PG8_MMA(1, 0, At, B0); PG8_MMA(1, 1, At, B1); PG8_BAR; PG8_SCHED; \
        } \
    } while (0)
    Unit cur, nxt; int ui = 0;
    if (!S.next(0, cur)) return;
    f32x4 acc[2][2][4][2];
#pragma unroll
    for (int a = 0; a < 2; ++a)
#pragma unroll
        for (int b = 0; b < 2; ++b)
#pragma unroll
            for (int m = 0; m < 4; ++m)
#pragma unroll
                for (int n = 0; n < 2; ++n) acc[a][b][m][n] = (f32x4){0.f, 0.f, 0.f, 0.f};
    bf16x8 At[4][2], B0[2][2], B1[2][2];
    constexpr size_t ksb = (size_t)K * 2;
    const char* cA = (const char*)g.A + (size_t)cur.pm * tA + (size_t)cur.pn * SH::APN + (size_t)cur.ks * ksb; const char* cB = (const char*)g.Bt + (size_t)cur.pn * tB + (size_t)cur.ks * ksb;
    PG8_STAGE(PG8_SB(0, 0), cB, voffB); PG8_STAGE(PG8_SB(0, 1), cB + hB, voffB); PG8_STAGE(PG8_SA(0, 0), cA, voffA); PG8_STAGE(PG8_SA(0, 1), cA + hA, voffA);
    if (wr == 1) PG8_BAR;
    PG8_WAIT_V(2); PG8_BAR;
    PG8_STAGE(PG8_SB(1, 0), cB + kstep, voffB); PG8_STAGE(PG8_SA(1, 0), cA + kstep, voffA); PG8_STAGE(PG8_SB(1, 1), cB + hB + kstep, voffB);
    PG8_WAIT_V(6); PG8_BAR;
    for (;;) {
        const bool has_next = S.next(ui + 1, nxt);
        const char* nA = has_next ? (const char*)g.A + (size_t)nxt.pm * tA + (size_t)nxt.pn * SH::APN + (size_t)nxt.ks * ksb : cA; const char* nB = has_next ? (const char*)g.Bt + (size_t)nxt.pn * tB + (size_t)nxt.ks * ksb : cB;
        if constexpr (Epi::HAS_MID) { PG8_KTILES(0, Epi::MID_T); E.mid(acc, cur, wr, wc, fr, fq); PG8_KTILES(Epi::MID_T, nt); } else { PG8_KTILES(0, nt); }
        if constexpr (ALIGN_EPI) { if (wr == 0) PG8_BAR; }
        E(acc, cur, wr, wc, fr, fq);
        if (!has_next) break;
#pragma unroll
        for (int a = 0; a < 2; ++a)
#pragma unroll
            for (int b = 0; b < 2; ++b)
#pragma unroll
                for (int m = 0; m < 4; ++m)
#pragma unroll
                    for (int n = 0; n < 2; ++n) acc[a][b][m][n] = (f32x4){0.f, 0.f, 0.f, 0.f};
        cur = nxt; cA = nA; cB = nB; ++ui;
        if constexpr (ALIGN_EPI) { if (wr == 1) PG8_BAR; }
    }
    PG8_WAIT_V(0);
    if constexpr (!ALIGN_EPI) { if (wr == 0) PG8_BAR; }
    PG8_BAR;
#undef PG8_SA
#undef PG8_SB
#undef PG8_STAGE
#undef PG8_LDA
#undef PG8_LDB
#undef PG8_MMA
#undef PG8_WAIT_V
#undef PG8_WAIT_L
#undef PG8_BAR
#undef PG8_SCHED
#undef PG8_KTILES
}
}

constexpr int D = 2048, SEQ = 4096, NB = 2, TP = NB * SEQ, NSEQ = 128, DSEQ = 4, TS = NSEQ * DSEQ, MR = TP + TS;
constexpr int PAST = 2048, PAGE = 128, NPG = PAST / PAGE, NPHYS = 2560;
constexpr int PW = 1024, PG = 256, PBUF = 15;
constexpr int HD = 128, NH = 16, NKV = 4, AW = 2048, KVW = 512;
constexpr int NIH = 16, IDD = 64, QIW = 1024, TOPK = 256;
constexpr int DFF = 5632, NADA = 6 * D, NCOND = NB + NSEQ;
constexpr int INW = 9296, N1 = 9472;
constexpr float EPS = 1e-6f;
constexpr int SKEYS = PAST + DSEQ, SC_S_LD = 2112;
constexpr unsigned NEWFLAG = 1u << 30;
static_assert(MR % 256 == 0 && N1 % 256 == 0 && DFF % 128 == 0, "tiles");

constexpr size_t OUT_Y = 0, OUT_KP = (size_t)MR * D, OUT_VP = OUT_KP + (size_t)TP * KVW, OUT_IKP = OUT_VP + (size_t)TP * KVW, OUT_PP = OUT_IKP + (size_t)TP * IDD,
                 OUT_KS = OUT_PP + (size_t)NB * PBUF * PW, OUT_VS = OUT_KS + (size_t)TS * KVW, OUT_IKS = OUT_VS + (size_t)TS * KVW, OUT_PS = OUT_IKS + (size_t)TS * IDD,
                 OUT_END = OUT_PS + (size_t)NSEQ * PBUF * PW;
static_assert(OUT_END == 29292544, "output size");

constexpr size_t MiB = 1u << 20;
constexpr size_t al(size_t x) { return (x + MiB - 1) / MiB * MiB; }
constexpr size_t WS_CTL = 0, CTL_ZERO_BYTES = MiB;
constexpr size_t WS_W1T = WS_CTL + MiB;
constexpr size_t WS_WUPT = WS_W1T + al((size_t)N1 * D * 2);
constexpr size_t WS_WOUTT = WS_WUPT + al((size_t)D * 3072 * 2);
constexpr size_t WS_WFIT = WS_WOUTT + al((size_t)D * D * 2);
constexpr size_t WS_WFOT = WS_WFIT + al((size_t)2 * DFF * D * 2);
constexpr size_t WS_WGT = WS_WFOT + al((size_t)D * DFF * 2);
constexpr size_t WS_SC = WS_WGT + al((size_t)PW * PG * 2);
constexpr size_t WS_MODS = WS_SC + al((size_t)144 * D * 2);
constexpr size_t WS_U = WS_MODS + al((size_t)NCOND * NADA * 4);
constexpr size_t WS_PIN = WS_U + al((size_t)MR * D * 2);
constexpr size_t WS_Q = WS_PIN + al((size_t)MR * PW * 4);
constexpr size_t WS_KB = WS_Q + al((size_t)MR * AW * 2);
constexpr size_t WS_VB = WS_KB + al((size_t)MR * KVW * 2);
constexpr size_t WS_QI = WS_VB + al((size_t)MR * KVW * 2);
constexpr size_t WS_KI = WS_QI + al((size_t)MR * QIW * 2);
constexpr size_t WS_WI = WS_KI + al((size_t)MR * IDD * 2);
constexpr size_t WS_GA = WS_WI + al((size_t)MR * NIH * 4);
constexpr size_t WS_GB = WS_GA + al((size_t)MR * D * 2);
constexpr size_t WS_DG = WS_GB + al((size_t)MR * D * 2);
constexpr size_t WS_PA = WS_DG + al((size_t)MR * PW * 2);
constexpr size_t WS_MIX = WS_PA + al((size_t)MR * 3072 * 2);
constexpr size_t WS_H = WS_MIX + al((size_t)MR * D * 2);
constexpr size_t WS_ACT = WS_H + al((size_t)MR * D * 4);
constexpr size_t WS_SCP = WS_ACT + al((size_t)MR * DFF * 2);
constexpr size_t WS_SCS = WS_SCP + al((size_t)TP * SEQ * 4);
constexpr size_t WS_SEL = WS_SCS + al((size_t)TS * SC_S_LD * 4);
constexpr size_t WS_CNT = WS_SEL + al((size_t)MR * TOPK * 4);
constexpr size_t WS_K8 = WS_CNT + al((size_t)MR * 4);
constexpr size_t WS_V8 = WS_K8 + al((size_t)TP * KVW);
constexpr size_t WS_KC8 = WS_V8 + al((size_t)TP * KVW);
constexpr size_t WS_VC8 = WS_KC8 + al((size_t)TS * NKV * TOPK * HD);
constexpr size_t WS_IDENT = WS_VC8 + al((size_t)TS * NKV * TOPK * HD);
constexpr size_t WS_END = WS_IDENT + MiB;

constexpr int CW_BAR = 4096;
constexpr int NWAVES = 8;
constexpr int LDS_BYTES = 147456;
constexpr int MISC_OFF = 143360;

#define GAS __attribute__((address_space(1)))
#define LAS __attribute__((address_space(3)))
typedef unsigned short bf16;
typedef unsigned v4u __attribute__((ext_vector_type(4)));
typedef unsigned v2u __attribute__((ext_vector_type(2)));
typedef float f32x4 __attribute__((ext_vector_type(4)));
typedef float f32x16 __attribute__((ext_vector_type(16)));
typedef short bf16x8 __attribute__((ext_vector_type(8)));
typedef unsigned short u16x4 __attribute__((ext_vector_type(4)));
#define LDS_WAIT() asm volatile("s_waitcnt lgkmcnt(0)" ::: "memory")
#define VM_WAIT() asm volatile("s_waitcnt vmcnt(0)" ::: "memory")
using pg8::cvt_pk_bf16;
__device__ __forceinline__ float bf2f(unsigned short b) { return __builtin_bit_cast(float, (unsigned)b << 16); }
__device__ __forceinline__ float sigmoidf_(float x) { return __builtin_amdgcn_rcpf(1.0f + __builtin_amdgcn_exp2f(-1.44269504f * x)); }
__device__ __forceinline__ float siluf_(float x) { return x * sigmoidf_(x); }
__device__ __forceinline__ float relu_(float x) { const int b = __builtin_bit_cast(int, x); return __builtin_bit_cast(float, b > 0 ? b : 0); }

__device__ __forceinline__ int fresh_lane() { unsigned ones = ~0u; asm volatile("" : "+v"(ones)); return (int)__builtin_amdgcn_mbcnt_hi(ones, __builtin_amdgcn_mbcnt_lo(ones, 0u)); }
#define XB_TMO      128
#define XB_XCNT(j)  (256  + 64 * (j))
#define XB_XSUB(j)  (1280 + 64 * (j))
#define XB_XGEN(j)  (2304 + 64 * (j))
#define XB_TOP      3328
#define XB_TOPGEN   3392
#define XCD_BAR_WORDS 3456
#define XB_SPIN_CAP (1u << 18)
__device__ __forceinline__ unsigned xb_ld(unsigned* p)              { return __hip_atomic_load(p, __ATOMIC_RELAXED, __HIP_MEMORY_SCOPE_AGENT); }
__device__ __forceinline__ unsigned xb_add(unsigned* p, unsigned v) { return __hip_atomic_fetch_add(p, v, __ATOMIC_RELAXED, __HIP_MEMORY_SCOPE_AGENT); }
__device__ __forceinline__ unsigned xb_xcc_id() { return (unsigned)__builtin_amdgcn_s_getreg((3 << 11) | 20) & 0xFu; }
#define XB_SPIN(cond, bar) do { unsigned _sp = 0; while (cond) {   \
    if ((++_sp & 255u) == 0u) { if (xb_ld(&(bar)[XB_TMO])) break; if (_sp > XB_SPIN_CAP) { atomicAdd(&(bar)[XB_TMO], 1u); break; } } } } while (0)
struct XcdBarrier { unsigned* bar; unsigned x; volatile LAS unsigned* st; };
__device__ __forceinline__ XcdBarrier xcd_barrier_post(unsigned* bar, volatile LAS unsigned* st, bool leader) {
    XcdBarrier b; b.bar = bar; b.x = xb_xcc_id(); b.st = st;
    if (leader) (void)xb_add(&bar[XB_XCNT(b.x)], 1u);
    return b;
}
__device__ __forceinline__ void xcd_barrier_complete(unsigned* bar, unsigned x, unsigned& nloc, unsigned& nx) {
    const unsigned G = gridDim.x * gridDim.y * gridDim.z;
    unsigned sum, cnt, mine, sp = 0u;
    for (;;) {
        sum = 0u; cnt = 0u; mine = 0u;
#pragma unroll
        for (unsigned j = 0; j < 16; ++j) { const unsigned c = xb_ld(&bar[XB_XCNT(j)]); sum += c; cnt += (c > 0u) ? 1u : 0u; mine = (j == x) ? c : mine; }
        if (sum == G) break;
        __builtin_amdgcn_s_sleep(1);
        if ((++sp & 255u) == 0u) { if (xb_ld(&bar[XB_TMO])) break; if (sp > XB_SPIN_CAP) { atomicAdd(&bar[XB_TMO], 1u); break; } }
    }
    nloc = mine > 0u ? mine : 1u; nx = cnt > 0u ? cnt : 1u;
}
__device__ __forceinline__ void xcd_barrier(const XcdBarrier& b, bool leader) {
    asm volatile("s_waitcnt vmcnt(0)" ::: "memory");
    __syncthreads();
    if (leader) {
        unsigned* bar = b.bar;
        __builtin_amdgcn_s_waitcnt(0);
        unsigned nloc = b.st[0], nx = b.st[1];
        if (nloc == 0u) { xcd_barrier_complete(bar, b.x, nloc, nx); b.st[0] = nloc; b.st[1] = nx; }
        const unsigned old = xb_add(&bar[XB_XSUB(b.x)], 1u);
        const unsigned gen = old / nloc;
        if (old + 1u == (gen + 1u) * nloc) {
            __builtin_amdgcn_fence(__ATOMIC_RELEASE, "agent");
            asm volatile("s_waitcnt vmcnt(0)" ::: "memory");
            const unsigned og = xb_add(&bar[XB_TOP], 1u);
            const unsigned tg = og / nx;
            if (og + 1u == (tg + 1u) * nx) xb_add(&bar[XB_TOPGEN], 1u);
            else XB_SPIN(xb_ld(&bar[XB_TOPGEN]) == tg, bar);
            __builtin_amdgcn_fence(__ATOMIC_ACQUIRE, "agent");
            xb_add(&bar[XB_XGEN(b.x)], 1u);
            asm volatile("s_waitcnt vmcnt(0)" ::: "memory");
        } else {
            XB_SPIN(xb_ld(&bar[XB_XGEN(b.x)]) == gen, bar);
            __builtin_amdgcn_fence(__ATOMIC_ACQUIRE, "agent");
            asm volatile("s_waitcnt vmcnt(0)" ::: "memory");
        }
    }
    __syncthreads();
}

struct Args { const float* in[22]; const int* page_table; float* out; unsigned char* ws; int ph_lo, ph_hi; };
struct Frame {
    LAS unsigned char* lds;
    int tid, lane, wave, vcu, G;
    const float *xp, *xs, *cache_k, *cache_v, *cache_ik, *state_pool, *cp, *cs, *w_ada, *b_ada, *g1, *w_in, *w_grp, *pool_scale, *w_up_pool, *w_up_attn, *w_out, *g2, *w_ffn_in, *w_ffn_out, *g_final;
    const int* page_table;
    float* out; unsigned char* ws;
};
__device__ __forceinline__ int bidx_of(int m) { return m < TP ? (m >> 12) : NB + ((m - TP) >> 2); }
__device__ __forceinline__ const float* xrow_of(const Frame& F, int m) { return m < TP ? F.xp + (size_t)m * D : F.xs + (size_t)(m - TP) * D; }

__device__ __forceinline__ int win_dst_row(int n) { return n < 5120 ? n : (n < 5184 ? 9216 + (n - 5120) : (n < 5200 ? 9280 + (n - 5184) : (n < 7248 ? 5120 + (n - 5200) : 7168 + (n - 7248)))); }
__device__ __forceinline__ int wfi_dst_row(int n) { const int j = n < DFF ? n : n - DFF; return (j >> 7) * 256 + (n < DFF ? 0 : 128) + (j & 127); }
struct TrItem { const float* W; bf16* WT; int K, N, ldt, coff, row_off, map, item; };
__device__ __forceinline__ void p0_load(const TrItem& t, float (&x)[32], int lane) {
    const int nblk = (t.N + 31) / 32, kb = t.item / nblk, nb = t.item % nblk, k0 = 64 * kb, n0 = 32 * nb;
    const int nl = n0 + (lane & 31); const bool ok = nl < t.N;
    const float* p = t.W + (size_t)(k0 + (lane >> 5)) * t.N + (ok ? nl : 0);
#pragma unroll
    for (int i = 0; i < 32; ++i) { const float v = __builtin_nontemporal_load(p + (size_t)(2 * i) * t.N); x[i] = ok ? v : 0.f; }
}
__device__ __forceinline__ void p0_store(const TrItem& t, const float (&x)[32], LAS float* scr, int lane) {
    const int nblk = (t.N + 31) / 32, kb = t.item / nblk, nb = t.item % nblk, k0 = 64 * kb, n0 = 32 * nb;
#pragma unroll
    for (int i = 0; i < 32; ++i) scr[(2 * i + (lane >> 5)) * 33 + (lane & 31)] = x[i];
    LDS_WAIT(); asm volatile("" ::: "memory");
    const int c = lane & 7;
#pragma unroll
    for (int j = 0; j < 4; ++j) { const int n = (lane >> 3) + 8 * j; const LAS float* sp = scr + (8 * c) * 33 + n;
        v4u o; o.x = cvt_pk_bf16(sp[0 * 33], sp[1 * 33]); o.y = cvt_pk_bf16(sp[2 * 33], sp[3 * 33]); o.z = cvt_pk_bf16(sp[4 * 33], sp[5 * 33]); o.w = cvt_pk_bf16(sp[6 * 33], sp[7 * 33]);
        const int ns = n0 + n;
        if (ns < t.N) { const int dr = t.map == 1 ? win_dst_row(ns) : (t.map == 2 ? wfi_dst_row(ns) : ns);
            *(v4u*)(t.WT + (size_t)(t.row_off + dr) * t.ldt + t.coff + k0 + 8 * c) = o; } }
    LDS_WAIT(); asm volatile("" ::: "memory");
}
__device__ __forceinline__ TrItem p0_decode(const Frame& F, int it) {
    bf16* W1T = (bf16*)(F.ws + WS_W1T); bf16* WUPT = (bf16*)(F.ws + WS_WUPT); bf16* WOUTT = (bf16*)(F.ws + WS_WOUTT); bf16* WFIT = (bf16*)(F.ws + WS_WFIT); bf16* WFOT = (bf16*)(F.ws + WS_WFOT); bf16* WGT = (bf16*)(F.ws + WS_WGT);
    constexpr int I_IN = (D / 64) * ((INW + 31) / 32), I_UP = (PW / 64) * (D / 32), I_UA = (AW / 64) * (D / 32), I_OUT = (D / 64) * (D / 32), I_FI = (D / 64) * (2 * DFF / 32), I_FO = (DFF / 64) * (D / 32), I_G1 = (PG / 64) * (PG / 32);
    int r = it;
    if (r < I_FI) return TrItem{F.w_ffn_in, WFIT, D, 2 * DFF, D, 0, 0, 2, r}; r -= I_FI;
    if (r < I_IN) return TrItem{F.w_in, W1T, D, INW, D, 0, 0, 1, r}; r -= I_IN;
    if (r < I_FO) return TrItem{F.w_ffn_out, WFOT, DFF, D, DFF, 0, 0, 0, r}; r -= I_FO;
    if (r < I_UA) return TrItem{F.w_up_attn, WUPT, AW, D, 3072, PW, 0, 0, r}; r -= I_UA;
    if (r < I_OUT) return TrItem{F.w_out, WOUTT, D, D, D, 0, 0, 0, r}; r -= I_OUT;
    if (r < I_UP) return TrItem{F.w_up_pool, WUPT, PW, D, 3072, 0, 0, 0, r}; r -= I_UP;
    const int g = r / I_G1; return TrItem{F.w_grp + (size_t)g * PG * PG, WGT, PG, PG, PG, 0, g * PG, 0, r % I_G1};
}
__device__ __forceinline__ void p0_prologue(Frame& F) {
    LAS float* scr = (LAS float*)(F.lds + F.wave * 16384);
    const int gw = F.vcu * NWAVES + F.wave, NGW = F.G * NWAVES;
    bf16* W1T = (bf16*)(F.ws + WS_W1T);
    constexpr int NITEMS = (D / 64) * ((INW + 31) / 32) + (PW / 64) * (D / 32) + (AW / 64) * (D / 32) + (D / 64) * (D / 32) + (D / 64) * (2 * DFF / 32) + (DFF / 64) * (D / 32) + 4 * (PG / 64) * (PG / 32);
    if (gw < NITEMS) {
        float xa[32], xb[32];
        TrItem ta = p0_decode(F, gw), tb = ta;
        p0_load(ta, xa, F.lane);
        for (int it = gw; it < NITEMS; it += 2 * NGW) {
            const bool hb = it + NGW < NITEMS, ha = it + 2 * NGW < NITEMS;
            if (hb) { tb = p0_decode(F, it + NGW); p0_load(tb, xb, F.lane); }
            p0_store(ta, xa, scr, F.lane);
            if (ha) { ta = p0_decode(F, it + 2 * NGW); p0_load(ta, xa, F.lane); }
            if (hb) p0_store(tb, xb, scr, F.lane);
        }
    }
    for (int i = gw * 64 + F.lane; i < 176 * 256; i += NGW * 64) *(v4u*)(W1T + (size_t)INW * D + (size_t)i * 8) = (v4u){0u, 0u, 0u, 0u};
    if (gw == 0) { unsigned* idn = (unsigned*)(F.ws + WS_IDENT); for (int i = F.lane; i < TOPK; i += 64) idn[i] = (unsigned)i; }
    for (int i = gw * 64 + F.lane; i < NCOND * NADA / 4; i += NGW * 64) *(f32x4*)((float*)(F.ws + WS_MODS) + (size_t)i * 4) = (f32x4){0.f, 0.f, 0.f, 0.f};
    bf16* SC = (bf16*)(F.ws + WS_SC);
    for (int i = gw * 64 + F.lane; i < 144 * D / 4; i += NGW * 64) { const int row = i / (D / 4), c4 = (i % (D / 4)) * 4;
        f32x4 v = (f32x4){0.f, 0.f, 0.f, 0.f};
        if (row < NB) v = *(const f32x4*)(F.cp + (size_t)row * D + c4); else if (row < NCOND) v = *(const f32x4*)(F.cs + (size_t)(row - NB) * D + c4);
        v2u o; o.x = cvt_pk_bf16(siluf_(v.x), siluf_(v.y)); o.y = cvt_pk_bf16(siluf_(v.z), siluf_(v.w)); *(v2u*)(SC + (size_t)row * D + c4) = o; }
    for (int i = gw * 64 + F.lane; i < NSEQ * 11 * (PW / 4); i += NGW * 64) { const int n = i / (11 * (PW / 4)), rem = i % (11 * (PW / 4)), j = rem / (PW / 4), c4 = (rem % (PW / 4)) * 4;
        *(f32x4*)(F.out + OUT_PS + ((size_t)n * PBUF + j) * PW + c4) = *(const f32x4*)(F.state_pool + ((size_t)n * PBUF + 4 + j) * PW + c4); }
}

constexpr int ADA_LD = 72;
__device__ __forceinline__ void p1_adaln(Frame& F) {
    const int lane = F.lane, r16 = lane & 15, g = lane >> 4, w = F.wave, tid = F.tid;
    const bf16* SC = (const bf16*)(F.ws + WS_SC); float* MODS = (float*)(F.ws + WS_MODS);
    LAS bf16* scb = (LAS bf16*)F.lds;
    for (int it = (int)blockIdx.x; it < 2 * (NADA / 128); it += F.G) {
        const int cb = it % (NADA / 128), kh = it / (NADA / 128), c0 = kh * (D / 128), cend = c0 + D / 128;
        const int n0 = cb * 128 + 16 * w;
        f32x4 acc[9];
#pragma unroll
        for (int rt = 0; rt < 9; ++rt) acc[rt] = (f32x4){0.f, 0.f, 0.f, 0.f};
        const float* wp = F.w_ada + (size_t)(8 * g) * NADA + n0 + r16;
        float xw[4][2][8]; v4u scr[3];
#pragma unroll
        for (int b = 0; b < 2; ++b)
#pragma unroll
            for (int ks = 0; ks < 2; ++ks)
#pragma unroll
                for (int j = 0; j < 8; ++j) xw[b][ks][j] = __builtin_nontemporal_load(wp + (size_t)(64 * (c0 + b) + 32 * ks + j) * NADA);
        __syncthreads();
#pragma unroll
        for (int p = 0; p < 3; ++p) { const int i = tid + 512 * p; if (i < 144 * 8) *(LAS v4u*)(scb + (i >> 3) * ADA_LD + (i & 7) * 8) = *(const v4u*)(SC + (size_t)(i >> 3) * D + 64 * c0 + (i & 7) * 8); }
        __syncthreads();
#pragma unroll 1
        for (int c = c0; c < cend; c += 4) {
#pragma unroll
            for (int h4 = 0; h4 < 4; ++h4) {
                const int cc = c + h4, cur = h4, n2 = (h4 + 2) & 3, lcur = h4 & 1, lnxt = lcur ^ 1; const bool more = cc + 1 < cend, more2 = cc + 2 < cend;
                if (more2) {
#pragma unroll
                    for (int ks = 0; ks < 2; ++ks)
#pragma unroll
                        for (int j = 0; j < 8; ++j) xw[n2][ks][j] = __builtin_nontemporal_load(wp + (size_t)(64 * (cc + 2) + 32 * ks + j) * NADA); }
                if (more) {
#pragma unroll
                    for (int p = 0; p < 3; ++p) { const int i = tid + 512 * p; if (i < 144 * 8) scr[p] = *(const v4u*)(SC + (size_t)(i >> 3) * D + 64 * (cc + 1) + (i & 7) * 8); } }
                const LAS bf16* sb = scb + lcur * 144 * ADA_LD + r16 * ADA_LD + 8 * g;
#pragma unroll
                for (int ks = 0; ks < 2; ++ks) { const float* x = xw[cur][ks];
                    v4u bw; bw.x = cvt_pk_bf16(x[0], x[1]); bw.y = cvt_pk_bf16(x[2], x[3]); bw.z = cvt_pk_bf16(x[4], x[5]); bw.w = cvt_pk_bf16(x[6], x[7]);
                    const bf16x8 bfrag = __builtin_bit_cast(bf16x8, bw);
#pragma unroll
                    for (int rt = 0; rt < 9; ++rt) { const bf16x8 af = *(const LAS bf16x8*)(sb + rt * 16 * ADA_LD + 32 * ks); acc[rt] = __builtin_amdgcn_mfma_f32_16x16x32_bf16(af, bfrag, acc[rt], 0, 0, 0); } }
                if (more) {
#pragma unroll
                    for (int p = 0; p < 3; ++p) { const int i = tid + 512 * p; if (i < 144 * 8) *(LAS v4u*)(scb + lnxt * 144 * ADA_LD + (i >> 3) * ADA_LD + (i & 7) * 8) = scr[p]; } }
                __syncthreads();
            }
        }
        const float bias = kh == 0 ? F.b_ada[n0 + r16] : 0.f;
#pragma unroll
        for (int rt = 0; rt < 9; ++rt)
#pragma unroll
            for (int i = 0; i < 4; ++i) { const int row = 16 * rt + 4 * g + i; if (row < NCOND) (void)__hip_atomic_fetch_add(MODS + (size_t)row * NADA + n0 + r16, acc[rt][i] + bias, __ATOMIC_RELAXED, __HIP_MEMORY_SCOPE_AGENT); }
    }
    __syncthreads();
}

__device__ __forceinline__ float wave_sum(float v) {
#pragma unroll
    for (int o = 1; o < 64; o <<= 1) v += __shfl_xor(v, o);
    return v;
}
template <int NSLAB>
__device__ __forceinline__ void modulate_row(const float* xrow, const float* g, const float* shift, const float* scale, bf16* orow, int lane, const float* slab, const float* gate, float* hrow) {
    f32x4 v[8]; float ss = 0.f;
#pragma unroll
    for (int j = 0; j < 8; ++j) { const int c = 4 * lane + 256 * j; v[j] = *(const f32x4*)(xrow + c);
        if (NSLAB > 0) { f32x4 a = (f32x4){0.f, 0.f, 0.f, 0.f};
#pragma unroll
            for (int sidx = 0; sidx < NSLAB; ++sidx) a += *(const f32x4*)(slab + (size_t)sidx * TS * D + c);
            v[j] += *(const f32x4*)(gate + c) * a; *(f32x4*)(hrow + c) = v[j]; }
        ss += (v[j].x * v[j].x + v[j].y * v[j].y) + (v[j].z * v[j].z + v[j].w * v[j].w); }
    const float rstd = 1.0f / sqrtf(wave_sum(ss) * (1.0f / D) + EPS);
#pragma unroll
    for (int j = 0; j < 8; ++j) { const int c = 4 * lane + 256 * j;
        const f32x4 gg = *(const f32x4*)(g + c), sh = *(const f32x4*)(shift + c), sc = *(const f32x4*)(scale + c);
        const f32x4 o = (v[j] * rstd * gg) * (sc + 1.0f) + sh;
        v2u w; w.x = cvt_pk_bf16(o.x, o.y); w.y = cvt_pk_bf16(o.z, o.w); *(v2u*)(orow + c) = w; }
}
template <int NSLAB>
__device__ __forceinline__ void final_norm_row(const float* xrow, const float* g, float* orow, int lane, const float* slab, const float* gate) {
    f32x4 v[8]; float ss = 0.f;
#pragma unroll
    for (int j = 0; j < 8; ++j) { const int c = 4 * lane + 256 * j; v[j] = *(const f32x4*)(xrow + c);
        if (NSLAB > 0) { f32x4 a = (f32x4){0.f, 0.f, 0.f, 0.f};
#pragma unroll
            for (int sidx = 0; sidx < NSLAB; ++sidx) a += *(const f32x4*)(slab + (size_t)sidx * TS * D + c);
            v[j] += *(const f32x4*)(gate + c) * a; }
        ss += (v[j].x * v[j].x + v[j].y * v[j].y) + (v[j].z * v[j].z + v[j].w * v[j].w); }
    const float rstd = 1.0f / sqrtf(wave_sum(ss) * (1.0f / D) + EPS);
#pragma unroll
    for (int j = 0; j < 8; ++j) { const int c = 4 * lane + 256 * j; const f32x4 gg = *(const f32x4*)(g + c); *(f32x4*)(orow + c) = v[j] * rstd * gg; }
}


__device__ __forceinline__ void row_load(f32x4 (&v)[8], const float* xrow, int lane) {
#pragma unroll
    for (int j = 0; j < 8; ++j) v[j] = *(const f32x4*)(xrow + 4 * lane + 256 * j);
}
__device__ __forceinline__ float row_rstd(const f32x4 (&v)[8]) {
    float ss = 0.f;
#pragma unroll
    for (int j = 0; j < 8; ++j) ss += (v[j].x * v[j].x + v[j].y * v[j].y) + (v[j].z * v[j].z + v[j].w * v[j].w);
    return 1.0f / sqrtf(wave_sum(ss) * (1.0f / D) + EPS);
}
__device__ __forceinline__ void row_store_mod(const f32x4 (&v)[8], float rstd, const float* g, const float* shift, const float* scale, bf16* orow, int lane) {
#pragma unroll
    for (int j = 0; j < 8; ++j) { const int c = 4 * lane + 256 * j;
        const f32x4 gg = *(const f32x4*)(g + c), sh = *(const f32x4*)(shift + c), sc = *(const f32x4*)(scale + c);
        const f32x4 o = (v[j] * rstd * gg) * (sc + 1.0f) + sh;
        v2u w; w.x = cvt_pk_bf16(o.x, o.y); w.y = cvt_pk_bf16(o.z, o.w); *(v2u*)(orow + c) = w; }
}
__device__ __forceinline__ void row_store_final(const f32x4 (&v)[8], float rstd, const float* g, float* orow, int lane) {
#pragma unroll
    for (int j = 0; j < 8; ++j) { const int c = 4 * lane + 256 * j; const f32x4 gg = *(const f32x4*)(g + c); *(f32x4*)(orow + c) = v[j] * rstd * gg; }
}
template <int NSLAB>
__device__ __forceinline__ f32x4 coop_row(const Frame& F, const float* xrow, const float* slab, const float* gate, LAS float* red, float& rstd) {
    const int c = 256 * F.wave + 4 * F.lane;
    f32x4 a = (f32x4){0.f, 0.f, 0.f, 0.f};
#pragma unroll
    for (int sidx = 0; sidx < NSLAB; ++sidx) a += *(const f32x4*)(slab + (size_t)sidx * TS * D + c);
    const f32x4 v = *(const f32x4*)(xrow + c) + *(const f32x4*)(gate + c) * a;
    const float ss = wave_sum((v.x * v.x + v.y * v.y) + (v.z * v.z + v.w * v.w));
    if (F.lane == 0) red[F.wave] = ss;
    __syncthreads();
    float t = 0.f;
#pragma unroll
    for (int w = 0; w < NWAVES; ++w) t += red[w];
    rstd = 1.0f / sqrtf(t * (1.0f / D) + EPS);
    return v;
}

__device__ __forceinline__ void st_bf16x8(bf16* p, const f32x4 a, const f32x4 b) { v4u w; w.x = cvt_pk_bf16(a[0], a[1]); w.y = cvt_pk_bf16(a[2], a[3]); w.z = cvt_pk_bf16(b[0], b[1]); w.w = cvt_pk_bf16(b[2], b[3]); *(v4u*)p = w; }
__device__ __forceinline__ v2u pk_fp8x8(const f32x4 a, const f32x4 b) { v2u w; int t = __builtin_amdgcn_cvt_pk_fp8_f32(a[0], a[1], 0, false); w.x = (unsigned)__builtin_amdgcn_cvt_pk_fp8_f32(a[2], a[3], t, true);
    t = __builtin_amdgcn_cvt_pk_fp8_f32(b[0], b[1], 0, false); w.y = (unsigned)__builtin_amdgcn_cvt_pk_fp8_f32(b[2], b[3], t, true); return w; }
__device__ __forceinline__ f32x4 sig4(const f32x4 a) { return (f32x4){sigmoidf_(a[0]), sigmoidf_(a[1]), sigmoidf_(a[2]), sigmoidf_(a[3])}; }
__device__ __forceinline__ void ld_bf16x8(const bf16* p, f32x4& a, f32x4& b) { const v4u w = *(const v4u*)p;
    a = (f32x4){__builtin_bit_cast(float, w.x << 16), __builtin_bit_cast(float, w.x & 0xffff0000u), __builtin_bit_cast(float, w.y << 16), __builtin_bit_cast(float, w.y & 0xffff0000u)};
    b = (f32x4){__builtin_bit_cast(float, w.z << 16), __builtin_bit_cast(float, w.z & 0xffff0000u), __builtin_bit_cast(float, w.w << 16), __builtin_bit_cast(float, w.w & 0xffff0000u)}; }

struct EpiIn {
    static constexpr bool PERM = true, HAS_MID = false; int mid_t;
    float* out; float* pin; bf16 *q, *kb, *vb, *qi, *ga, *gb, *ki; float* wi; unsigned char *k8, *v8;
    __device__ __forceinline__ void mid(pg8::f32x4 (&)[2][2][4][2], const pg8::Unit&, int, int, int, int) const {}
#define EPI_LOOP(BODY) _Pragma("unroll") for (int ai = 0; ai < 2; ++ai) _Pragma("unroll") for (int m = 0; m < 4; ++m) { const int r = row0 + ai * 128 + m * 16; _Pragma("unroll") for (int bj = 0; bj < 2; ++bj) { \
        const int cl = cl0 + bj * 128; const f32x4 v0 = acc[ai][bj][m][0], v1 = acc[ai][bj][m][1]; BODY } }
    __device__ __forceinline__ void operator()(const pg8::f32x4 (&acc)[2][2][4][2], const pg8::Unit& u, int wr, int wc, int fr, int fq) const {
        const int pn = u.pn, row0 = u.pm * 256 + wr * 64 + fr, cl0 = wc * 32 + 8 * fq;
        if (pn < 4) {
            EPI_LOOP({ const int c = pn * 256 + cl; float* p = pin + (size_t)r * PW + c; *(f32x4*)p = v0; *(f32x4*)(p + 4) = v1;
                if (r < TP) { const int t = r & (SEQ - 1); if (t >= SEQ - PBUF) { float* o = out + OUT_PP + ((size_t)(r >> 12) * PBUF + (t - (SEQ - PBUF))) * PW + c; *(f32x4*)o = v0; *(f32x4*)(o + 4) = v1; } }
                else { const int rr = r - TP; float* o = out + OUT_PS + ((size_t)(rr >> 2) * PBUF + 11 + (rr & 3)) * PW + c; *(f32x4*)o = v0; *(f32x4*)(o + 4) = v1; } })
        } else if (pn >= 12 && pn < 16) { const bool isv = pn >= 14; const int cb = ((pn - 12) & 1) * 256; bf16* hb = isv ? vb : kb; unsigned char* h8 = isv ? v8 : k8;
            float* op = out + (isv ? OUT_VP : OUT_KP); float* os = out + (isv ? OUT_VS : OUT_KS);
            EPI_LOOP({ const int c = cb + cl; st_bf16x8(hb + (size_t)r * KVW + c, v0, v1);
                float* o = r < TP ? op + (size_t)r * KVW + c : os + (size_t)(r - TP) * KVW + c; *(f32x4*)o = v0; *(f32x4*)(o + 4) = v1;
                if (r < TP) { const int d0 = c & 127; *(v2u*)(h8 + (size_t)r * KVW + (isv ? c : (c & ~127) + ((d0 >> 3) & 3) * 32 + (d0 >> 5) * 8)) = pk_fp8x8(v0, v1); } })
        } else if (pn >= 36) {
            EPI_LOOP({ if (cl < IDD) { st_bf16x8(ki + (size_t)r * IDD + cl, v0, v1);
                           float* o = r < TP ? out + OUT_IKP + (size_t)r * IDD + cl : out + OUT_IKS + (size_t)(r - TP) * IDD + cl; *(f32x4*)o = v0; *(f32x4*)(o + 4) = v1; }
                       else if (cl < IDD + NIH) { float* o = wi + (size_t)r * NIH + (cl - IDD); *(f32x4*)o = v0; *(f32x4*)(o + 4) = v1; } })
        } else if (pn < 12) { bf16* qb = q + (pn - 4) * 256;
            EPI_LOOP({ st_bf16x8(qb + (size_t)r * AW + cl, v0, v1); })
        } else if (pn < 20) { bf16* qb = qi + (pn - 16) * 256;
            EPI_LOOP({ st_bf16x8(qb + (size_t)r * QIW + cl, v0, v1); })
        } else if (pn < 36) { bf16* gp = (pn < 28 ? ga + (pn - 20) * 256 : gb + (pn - 28) * 256);
            EPI_LOOP({ st_bf16x8(gp + (size_t)r * D + cl, sig4(v0), sig4(v1)); })
        }
    }
#undef EPI_LOOP
};
struct EpiPool {
    static constexpr bool PERM = true, HAS_MID = false; int mid_t;
    bf16* pa; const float* scale;
    __device__ __forceinline__ void mid(pg8::f32x4 (&)[2][2][4][2], const pg8::Unit&, int, int, int, int) const {}
    __device__ __forceinline__ void operator()(const pg8::f32x4 (&acc)[2][2][4][2], const pg8::Unit& u, int wr, int wc, int fr, int fq) const {
        const int row0 = u.pm * 256 + wr * 64 + fr, c0 = u.pn * 256 + wc * 32 + 8 * fq;
        f32x4 s[2][2];
#pragma unroll
        for (int bj = 0; bj < 2; ++bj) { s[bj][0] = *(const f32x4*)(scale + c0 + bj * 128); s[bj][1] = *(const f32x4*)(scale + c0 + bj * 128 + 4); }
#pragma unroll
        for (int ai = 0; ai < 2; ++ai)
#pragma unroll
            for (int m = 0; m < 4; ++m) { const int r = row0 + ai * 128 + m * 16;
#pragma unroll
                for (int bj = 0; bj < 2; ++bj) st_bf16x8(pa + (size_t)r * 3072 + c0 + bj * 128, acc[ai][bj][m][0] * s[bj][0], acc[ai][bj][m][1] * s[bj][1]); }
    }
};
template <bool SECOND> struct EpiMix {
    static constexpr bool PERM = true, HAS_MID = false; int mid_t;
    const bf16* gate; float* t1; bf16* mix;
    __device__ __forceinline__ void mid(pg8::f32x4 (&)[2][2][4][2], const pg8::Unit&, int, int, int, int) const {}
    __device__ __forceinline__ void operator()(const pg8::f32x4 (&acc)[2][2][4][2], const pg8::Unit& u, int wr, int wc, int fr, int fq) const {
        const int row0 = u.pm * 256 + wr * 64 + fr, c0 = u.pn * 256 + wc * 32 + 8 * fq;
#pragma unroll
        for (int ai = 0; ai < 2; ++ai)
#pragma unroll
            for (int m = 0; m < 4; ++m) { const size_t ro = (size_t)(row0 + ai * 128 + m * 16) * D + c0;
#pragma unroll
                for (int bj = 0; bj < 2; ++bj) { f32x4 b0, b1; ld_bf16x8(gate + ro + bj * 128, b0, b1); float* tp = t1 + ro + bj * 128;
                    (void)tp;
                    if (!SECOND) st_bf16x8(mix + ro + bj * 128, acc[ai][bj][m][0] * b0, acc[ai][bj][m][1] * b1);
                    else { f32x4 x0, x1; ld_bf16x8(mix + ro + bj * 128, x0, x1); st_bf16x8(mix + ro + bj * 128, x0 + acc[ai][bj][m][0] * b0, x1 + acc[ai][bj][m][1] * b1); } }
                if (m & 1) asm volatile("" ::: "memory"); }
    }
};
struct EpiMixFused {
    static constexpr bool PERM = true, HAS_MID = true; static constexpr int MID_T = PW / 64; int mid_t;
    const bf16 *ga, *gb; bf16* mix;
    __device__ __forceinline__ void mid(pg8::f32x4 (&acc)[2][2][4][2], const pg8::Unit& u, int wr, int wc, int fr, int fq) const {
        int row0 = u.pm * 256 + wr * 64 + fr, c0 = u.pn * 256 + wc * 32 + 8 * fq;
        asm volatile("" : "+v"(row0), "+v"(c0));
#pragma unroll
        for (int ai = 0; ai < 2; ++ai)
#pragma unroll
            for (int m = 0; m < 4; ++m) { const size_t ro = (size_t)(row0 + ai * 128 + m * 16) * D + c0;
#pragma unroll
                for (int bj = 0; bj < 2; ++bj) { f32x4 a0, a1, b0, b1; ld_bf16x8(ga + ro + bj * 128, a0, a1); ld_bf16x8(gb + ro + bj * 128, b0, b1);
#pragma unroll
                    for (int i = 0; i < 4; ++i) { acc[ai][bj][m][0][i] *= a0[i] * __builtin_amdgcn_rcpf(b0[i]); acc[ai][bj][m][1][i] *= a1[i] * __builtin_amdgcn_rcpf(b1[i]); } }
                asm volatile("" ::: "memory"); }
    }
    __device__ __forceinline__ void operator()(const pg8::f32x4 (&acc)[2][2][4][2], const pg8::Unit& u, int wr, int wc, int fr, int fq) const {
        const int row0 = u.pm * 256 + wr * 64 + fr, c0 = u.pn * 256 + wc * 32 + 8 * fq;
#pragma unroll
        for (int ai = 0; ai < 2; ++ai)
#pragma unroll
            for (int m = 0; m < 4; ++m) { const size_t ro = (size_t)(row0 + ai * 128 + m * 16) * D + c0;
#pragma unroll
                for (int bj = 0; bj < 2; ++bj) { f32x4 b0, b1; ld_bf16x8(gb + ro + bj * 128, b0, b1); st_bf16x8(mix + ro + bj * 128, acc[ai][bj][m][0] * b0, acc[ai][bj][m][1] * b1); }
                if (m & 1) asm volatile("" ::: "memory"); }
    }
};
struct EpiRes {
    static constexpr bool PERM = false, HAS_MID = false; int mid_t;
    const float *base_p, *base_s; float* o; const float* mods; int moff;
    __device__ __forceinline__ void mid(pg8::f32x4 (&)[2][2][4][2], const pg8::Unit&, int, int, int, int) const {}
    __device__ __forceinline__ void operator()(const pg8::f32x4 (&acc)[2][2][4][2], const pg8::Unit& u, int wr, int wc, int fr, int fq) const {
        const int row0 = u.pm * 256 + wr * 64 + fr, c0 = u.pn * 256 + wc * 32 + 4 * fq;
#pragma unroll
        for (int ai = 0; ai < 2; ++ai)
#pragma unroll
            for (int m = 0; m < 4; ++m) { const int r = row0 + ai * 128 + m * 16;
                const float* bp = (r < TP ? base_p + (size_t)r * D : base_s + (size_t)(r - TP) * D) + c0; const float* mp = mods + (size_t)bidx_of(r) * NADA + moff + c0; float* op = o + (size_t)r * D + c0;
#pragma unroll
                for (int bj = 0; bj < 2; ++bj)
#pragma unroll
                    for (int n = 0; n < 2; ++n) { const int co = bj * 128 + n * 16; *(f32x4*)(op + co) = *(const f32x4*)(bp + co) + *(const f32x4*)(mp + co) * acc[ai][bj][m][n]; }
                if (m & 1) asm volatile("" ::: "memory"); }
    }
};
template <bool GATED> struct EpiSlab {
    static constexpr bool PERM = false, HAS_MID = false; int mid_t;
    float* slab; const bf16 *ga, *gb; int gsplit;
    __device__ __forceinline__ void mid(pg8::f32x4 (&)[2][2][4][2], const pg8::Unit&, int, int, int, int) const {}
    __device__ __forceinline__ void operator()(const pg8::f32x4 (&acc)[2][2][4][2], const pg8::Unit& u, int wr, int wc, int fr, int fq) const {
        const int row0 = u.pm * 256 + wr * 64 + fr, c0 = u.pn * 256 + wc * 32 + 4 * fq;
        const bf16* gt = u.ks < gsplit ? ga : gb;
#pragma unroll
        for (int ai = 0; ai < 2; ++ai)
#pragma unroll
            for (int m = 0; m < 4; ++m) { const int r = row0 + ai * 128 + m * 16; float* op = slab + ((size_t)u.ks * TS + (r - TP)) * D + c0;
#pragma unroll
                for (int bj = 0; bj < 2; ++bj)
#pragma unroll
                    for (int n = 0; n < 2; ++n) { const int co = bj * 128 + n * 16; f32x4 v = acc[ai][bj][m][n];
                        if (GATED) { const v2u w = *(const v2u*)(gt + (size_t)r * D + c0 + co);
                            v *= (f32x4){__builtin_bit_cast(float, w.x << 16), __builtin_bit_cast(float, w.x & 0xffff0000u), __builtin_bit_cast(float, w.y << 16), __builtin_bit_cast(float, w.y & 0xffff0000u)}; }
                        *(f32x4*)(op + co) = v; }
                if (m & 1) asm volatile("" ::: "memory"); }
    }
};
struct EpiFfn {
    static constexpr bool PERM = true, HAS_MID = false; int mid_t;
    bf16* act;
    __device__ __forceinline__ void mid(pg8::f32x4 (&)[2][2][4][2], const pg8::Unit&, int, int, int, int) const {}
    __device__ __forceinline__ void operator()(const pg8::f32x4 (&acc)[2][2][4][2], const pg8::Unit& u, int wr, int wc, int fr, int fq) const {
        const int row0 = u.pm * 256 + wr * 64 + fr, c0 = u.pn * 128 + wc * 32 + 8 * fq;
#pragma unroll
        for (int ai = 0; ai < 2; ++ai)
#pragma unroll
            for (int m = 0; m < 4; ++m) { const int r = row0 + ai * 128 + m * 16; f32x4 o0, o1;
#pragma unroll
                for (int i = 0; i < 4; ++i) { o0[i] = siluf_(acc[ai][0][m][0][i]) * acc[ai][1][m][0][i]; o1[i] = siluf_(acc[ai][0][m][1][i]) * acc[ai][1][m][1][i]; }
                st_bf16x8(act + (size_t)r * DFF + c0, o0, o1); }
    }
};

template <int G>
__device__ __forceinline__ void pool_d_block(const float* PIN, bf16* DG, int b, int t0, int lane) {
    constexpr int W = 2 << G, HL = W - 1, c = G * PG;
    f32x4 x[16 + HL];
#pragma unroll
    for (int j = 0; j < 16 + HL; ++j) { const int t = t0 - HL + j; x[j] = t >= 0 ? *(const f32x4*)(PIN + (size_t)(b * SEQ + t) * PW + c + 4 * lane) : (f32x4){0.f, 0.f, 0.f, 0.f}; }
    f32x4 sw = x[0];
#pragma unroll
    for (int j = 1; j <= HL; ++j) sw += x[j];
#pragma unroll
    for (int i = 0; i < 16; ++i) { const int t = t0 + i; if (i > 0) sw += x[HL + i] - x[i - 1];
        const float cnt = (float)(t + 1 < W ? t + 1 : W); const f32x4 d = sw * (1.0f / cnt) - x[HL + i];
        v2u o; o.x = cvt_pk_bf16(d.x, d.y); o.y = cvt_pk_bf16(d.z, d.w); *(v2u*)(DG + ((size_t)G * MR + b * SEQ + t) * PG + 4 * lane) = o; }
}
__device__ __forceinline__ void p3_pool_d(Frame& F) {
    const int gw = F.vcu * NWAVES + F.wave, NGW = F.G * NWAVES, lane = F.lane;
    const float* PIN = (const float*)(F.ws + WS_PIN); bf16* DG = (bf16*)(F.ws + WS_DG);
    for (int job = gw; job < 4 * (TP / 16); job += NGW) { const int g = job / (TP / 16), blk = job % (TP / 16), b = blk / (SEQ / 16), t0 = (blk % (SEQ / 16)) * 16;
        if (g == 0) pool_d_block<0>(PIN, DG, b, t0, lane); else if (g == 1) pool_d_block<1>(PIN, DG, b, t0, lane); else if (g == 2) pool_d_block<2>(PIN, DG, b, t0, lane); else pool_d_block<3>(PIN, DG, b, t0, lane); }
    for (int m = TP + gw; m < MR; m += NGW) {
#pragma unroll
        for (int g = 0; g < 4; ++g) { const int w = 2 << g, c = g * PG + 4 * lane;
            const int rr = m - TP, n = rr >> 2, tt = rr & 3; const f32x4 cur = *(const f32x4*)(PIN + (size_t)m * PW + c); f32x4 sm = cur;
#pragma unroll
            for (int j = 1; j < w; ++j) { const int q = PBUF + tt - j;
                sm += q >= PBUF ? *(const f32x4*)(PIN + (size_t)(TP + 4 * n + q - PBUF) * PW + c) : *(const f32x4*)(F.state_pool + ((size_t)n * PBUF + q) * PW + c); }
            const f32x4 d = sm * (1.0f / (float)w) - cur;
            v2u o; o.x = cvt_pk_bf16(d.x, d.y); o.y = cvt_pk_bf16(d.z, d.w); *(v2u*)(DG + ((size_t)g * MR + m) * PG + 4 * lane) = o; }
    }
}

constexpr int QS_LD = QIW + 8;
__device__ __forceinline__ void idx_item(Frame& F, int qrow0  , int kt_lo, int kt_hi) {
    const int lane = F.lane, q = lane & 31, h = lane >> 5;
    const bf16* QI = (const bf16*)(F.ws + WS_QI); const bf16* KI = (const bf16*)(F.ws + WS_KI); const float* WI = (const float*)(F.ws + WS_WI);
    LAS bf16* Qs = (LAS bf16*)F.lds;
    __syncthreads();
    const bf16* kbase = KI + (size_t)((qrow0 & ~(SEQ - 1)) + q) * IDD + 8 * h;
    bf16x8 an[4];
    { const int kt0 = kt_lo + F.wave; if (kt0 < kt_hi) {
#pragma unroll
        for (int ks = 0; ks < 4; ++ks) an[ks] = *(const bf16x8*)(kbase + (size_t)kt0 * 32 * IDD + 16 * ks); } }
#pragma unroll
    for (int i = 0; i < 8; ++i) { const int ch = F.tid + 512 * i, r = ch >> 7, c8 = (ch & 127) * 8;
        *(LAS v4u*)(Qs + r * QS_LD + c8) = *(const v4u*)(QI + (size_t)(qrow0 + r) * QIW + c8); }
    LAS float* Ws = (LAS float*)(F.lds + 32 * QS_LD * 2);
    { const int hq = F.tid & 31, hh = F.tid >> 5; Ws[F.tid] = WI[(size_t)(qrow0 + hq) * NIH + hh] * 0.03125f; }
    __syncthreads();
    for (int kt = kt_lo + F.wave; kt < kt_hi; kt += NWAVES) {
        bf16x8 a[4];
#pragma unroll
        for (int ks = 0; ks < 4; ++ks) a[ks] = an[ks];
        if (kt + NWAVES < kt_hi) {
#pragma unroll
            for (int ks = 0; ks < 4; ++ks) an[ks] = *(const bf16x8*)(kbase + (size_t)(kt + NWAVES) * 32 * IDD + 16 * ks); }
        f32x16 sc;
#pragma unroll
        for (int i = 0; i < 16; ++i) sc[i] = 0.f;
        const LAS bf16* qb = Qs + q * QS_LD + 8 * h;
#pragma unroll 4
        for (int hd = 0; hd < NIH; ++hd) {
            f32x16 c;
#pragma unroll
            for (int i = 0; i < 16; ++i) c[i] = 0.f;
#pragma unroll
            for (int ks = 0; ks < 4; ++ks) { const bf16x8 b = *(const LAS bf16x8*)(qb + hd * IDD + 16 * ks); c = __builtin_amdgcn_mfma_f32_32x32x16_bf16(a[ks], b, c, 0, 0, 0); }
            const float wh = Ws[hd * 32 + q];
#pragma unroll
            for (int i = 0; i < 16; ++i) sc[i] += relu_(c[i]) * wh;
        }
        float* sp = (float*)(F.ws + WS_SCP) + (size_t)(qrow0 + q) * SEQ + kt * 32 + 4 * h;
#pragma unroll
        for (int a4 = 0; a4 < 4; ++a4) *(f32x4*)(sp + 8 * a4) = (f32x4){sc[4 * a4], sc[4 * a4 + 1], sc[4 * a4 + 2], sc[4 * a4 + 3]};
    }
}
__device__ __forceinline__ void idx_sample_item(Frame& F, int n, int kt_lo, int kt_hi) {
    const int lane = F.lane, q = lane & 31, h = lane >> 5;
    const bf16* QI = (const bf16*)(F.ws + WS_QI); const bf16* KI = (const bf16*)(F.ws + WS_KI); const float* WI = (const float*)(F.ws + WS_WI);
    bf16x8 qa[2][4]; f32x4 wr[2][4];
#pragma unroll
    for (int rt = 0; rt < 2; ++rt) { const bf16* qp = QI + (size_t)(TP + 4 * n + 2 * rt + (q >> 4)) * QIW + (q & 15) * IDD + 8 * h;
#pragma unroll
        for (int ks = 0; ks < 4; ++ks) qa[rt][ks] = *(const bf16x8*)(qp + 16 * ks);
#pragma unroll
        for (int a = 0; a < 4; ++a) wr[rt][a] = *(const f32x4*)(WI + (size_t)(TP + 4 * n + 2 * rt + (a >> 1)) * NIH + 8 * (a & 1) + 4 * h) * 0.03125f; }
    f32x4 cur[8], nxt[8];
    int kt = kt_lo + F.wave;
    if (kt < kt_hi && kt < PAST / 32) { const int pg = F.page_table[n * NPG + (kt >> 2)]; const float* kp = F.cache_ik + ((size_t)pg * PAGE + ((kt & 3) * 32 + q)) * IDD + 8 * h;
#pragma unroll
        for (int ks = 0; ks < 4; ++ks) { cur[2 * ks] = *(const f32x4*)(kp + 16 * ks); cur[2 * ks + 1] = *(const f32x4*)(kp + 16 * ks + 4); } }
    for (; kt < kt_hi; kt += NWAVES) {
        bf16x8 kf[4];
        const int ktn = kt + NWAVES; const bool pn = ktn < kt_hi && ktn < PAST / 32;
        if (pn) { const int pg = F.page_table[n * NPG + (ktn >> 2)]; const float* kp = F.cache_ik + ((size_t)pg * PAGE + ((ktn & 3) * 32 + q)) * IDD + 8 * h;
#pragma unroll
            for (int ks = 0; ks < 4; ++ks) { nxt[2 * ks] = *(const f32x4*)(kp + 16 * ks); nxt[2 * ks + 1] = *(const f32x4*)(kp + 16 * ks + 4); } }
        if (kt < PAST / 32) {
#pragma unroll
            for (int ks = 0; ks < 4; ++ks) { const f32x4 x0 = cur[2 * ks], x1 = cur[2 * ks + 1];
                v4u t; t.x = cvt_pk_bf16(x0.x, x0.y); t.y = cvt_pk_bf16(x0.z, x0.w); t.z = cvt_pk_bf16(x1.x, x1.y); t.w = cvt_pk_bf16(x1.z, x1.w); kf[ks] = __builtin_bit_cast(bf16x8, t); } }
        else { const int s = kt * 32 + q; const bf16* kp = KI + (size_t)(TP + 4 * n + ((s - PAST) & 3)) * IDD + 8 * h;
#pragma unroll
            for (int ks = 0; ks < 4; ++ks) kf[ks] = *(const bf16x8*)(kp + 16 * ks); }
#pragma unroll
        for (int rt = 0; rt < 2; ++rt) {
            f32x16 c;
#pragma unroll
            for (int i = 0; i < 16; ++i) c[i] = 0.f;
#pragma unroll
            for (int ks = 0; ks < 4; ++ks) c = __builtin_amdgcn_mfma_f32_32x32x16_bf16(qa[rt][ks], kf[ks], c, 0, 0, 0);
            float p0 = 0.f, p1 = 0.f;
#pragma unroll
            for (int i = 0; i < 8; ++i) { p0 += relu_(c[i]) * wr[rt][i >> 2][i & 3]; p1 += relu_(c[8 + i]) * wr[rt][2 + (i >> 2)][i & 3]; }
            p0 += __shfl_xor(p0, 32); p1 += __shfl_xor(p1, 32);
            float* sp = (float*)(F.ws + WS_SCS) + (size_t)(4 * n + 2 * rt + h) * SC_S_LD + kt * 32 + q;
            *sp = h ? p1 : p0;
        }
        if (pn) {
#pragma unroll
            for (int j = 0; j < 8; ++j) cur[j] = nxt[j]; }
    }
}
__device__ __forceinline__ void p3_indexer(Frame& F) {
    for (int it = F.vcu; it < 256; it += F.G) { const int b = it >> 7, x = it & 127, y = 127 - x;
        idx_item(F, b * SEQ + 32 * x, 0, (x + 2) >> 1);
        idx_item(F, b * SEQ + 32 * y, (y + 2) >> 1, y + 1); }
    __syncthreads();
    for (int it = F.vcu; it < 2 * NSEQ; it += F.G) { const int n = it >> 1, hf = it & 1; idx_sample_item(F, n, hf ? 33 : 0, hf ? 65 : 33); }
}

constexpr int AT_WAVE_LDS = 17920;
__device__ __forceinline__ void sample_copy(Frame& F, int m, int kvh) {
    int lane = fresh_lane(); asm volatile("" : "+v"(lane));
    const int half = lane >> 5, d0 = 4 * (lane & 31), nseq = (m - TP) >> 2;
    const unsigned* sel = (const unsigned*)(F.ws + WS_SEL) + (size_t)m * TOPK;
    unsigned char* kc = F.ws + WS_KC8 + ((size_t)(m - TP) * NKV + kvh) * (TOPK * HD);
    unsigned char* vc = F.ws + WS_VC8 + ((size_t)(m - TP) * NKV + kvh) * (TOPK * HD);
    const int kpos = ((d0 >> 3) & 3) * 32 + (d0 >> 5) * 8 + (d0 & 7);
    const bf16* KB = (const bf16*)(F.ws + WS_KB); const bf16* VB = (const bf16*)(F.ws + WS_VB);
    const v4u sl4 = *(const v4u*)(sel + 4 * lane);
#pragma unroll 1
    for (int p0 = 0; p0 < TOPK / 2; p0 += 16) {
        unsigned e[16]; f32x4 xk[16], xv[16];
#pragma unroll
        for (int i = 0; i < 16; ++i) { const int src = (p0 + i) >> 1;
            const unsigned r0 = (unsigned)__builtin_amdgcn_readlane((int)((i & 1) ? sl4.z : sl4.x), src), r1 = (unsigned)__builtin_amdgcn_readlane((int)((i & 1) ? sl4.w : sl4.y), src);
            e[i] = half ? r1 : r0; }
#pragma unroll
        for (int i = 0; i < 16; ++i) {
            if (e[i] < NEWFLAG) { const size_t ro = ((size_t)e[i] * NKV + kvh) * HD + d0; xk[i] = *(const f32x4*)(F.cache_k + ro); xv[i] = *(const f32x4*)(F.cache_v + ro); }
            else { const size_t ro = (size_t)(TP + 4 * nseq + (e[i] & 3u)) * KVW + kvh * HD + d0; const v2u a = *(const v2u*)(KB + ro), b = *(const v2u*)(VB + ro);
                xk[i] = (f32x4){__builtin_bit_cast(float, a.x << 16), __builtin_bit_cast(float, a.x & 0xffff0000u), __builtin_bit_cast(float, a.y << 16), __builtin_bit_cast(float, a.y & 0xffff0000u)};
                xv[i] = (f32x4){__builtin_bit_cast(float, b.x << 16), __builtin_bit_cast(float, b.x & 0xffff0000u), __builtin_bit_cast(float, b.y << 16), __builtin_bit_cast(float, b.y & 0xffff0000u)}; } }
#pragma unroll
        for (int i = 0; i < 16; ++i) { const int slot = 2 * (p0 + i) + half;
            int t = __builtin_amdgcn_cvt_pk_fp8_f32(xk[i][0], xk[i][1], 0, false); *(unsigned*)(kc + slot * HD + kpos) = (unsigned)__builtin_amdgcn_cvt_pk_fp8_f32(xk[i][2], xk[i][3], t, true);
            t = __builtin_amdgcn_cvt_pk_fp8_f32(xv[i][0], xv[i][1], 0, false); *(unsigned*)(vc + slot * HD + d0) = (unsigned)__builtin_amdgcn_cvt_pk_fp8_f32(xv[i][2], xv[i][3], t, true); }
    }
}
__device__ __forceinline__ int lane_count_total7(int cv) {
    int t = 0;
#pragma unroll
    for (int b = 0; b < 7; ++b) t += __popcll(__ballot((cv >> b) & 1)) << b;
    return t;
}
__device__ __forceinline__ int lane_count_total(int cv) {
    int t = 0;
#pragma unroll
    for (int b = 0; b < 5; ++b) t += __popcll(__ballot((cv >> b) & 1)) << b;
    return t;
}
struct TkSlot { bool att, smp; int j, m, nvalid; };
__device__ __forceinline__ TkSlot tk_decode(int slot, int nP, int nS, int wave, int gw, int NGW) {
    TkSlot t; int k;
    if (wave & 4) { t.smp = slot < 2 * nS; k = t.smp ? slot : slot - 2 * nS; } else { t.smp = slot >= nP; k = t.smp ? slot - nP : slot; }
    t.att = t.smp && (k & 1); if (t.smp) k >>= 1;
    t.j = gw + k * NGW;
    t.m = t.smp ? TP + (t.j >> 2) : (t.j & ~2047) + ((t.j >> 11) & 1 ? 2047 - (t.j & 2047) : (t.j & 2047));
    t.nvalid = t.smp ? PAST + 1 + ((t.m - TP) & 3) : (t.m & (SEQ - 1)) + 1;
    return t;
}
__device__ __forceinline__ const float* tk_scores(const Frame& F, const TkSlot& t) { return t.smp ? (const float*)(F.ws + WS_SCS) + (size_t)(t.m - TP) * SC_S_LD : (const float*)(F.ws + WS_SCP) + (size_t)t.m * SEQ; }
__device__ __forceinline__ void tk_load(float (&v)[64], const float* sp, int nvalid, int lane) {
    const int nreg = (nvalid + 63) >> 6;
#pragma unroll
    for (int i = 0; i < 64; ++i) { const int s = i * 64 + lane; const bool ok = i < nreg && s < nvalid; v[i] = ok ? sp[s] : -INFINITY; }
}
__device__ __forceinline__ void p4_topk(Frame& F) {
    const int gw = F.vcu * NWAVES + F.wave, NGW = F.G * NWAVES;
    unsigned* SEL = (unsigned*)(F.ws + WS_SEL); unsigned* CNT = (unsigned*)(F.ws + WS_CNT);
    const int nP = gw < TP ? (TP - gw + NGW - 1) / NGW : 0, nS = gw < TS * NKV ? (TS * NKV - gw + NGW - 1) / NGW : 0;
    LAS unsigned char* wl = F.lds + F.wave * AT_WAVE_LDS;
    bool pre = false;
#pragma unroll 1
    for (int slot = 0; slot < nP + 2 * nS; ++slot) {
        const TkSlot cur = tk_decode(slot, nP, nS, F.wave, gw, NGW);
        if (cur.att) { sample_copy(F, TP + (cur.j >> 2), cur.j & 3); continue; }
        int lane = fresh_lane(); asm volatile("" : "+v"(lane));
        const bool smp = cur.smp; const int m = cur.m, nvalid = cur.nvalid;
        unsigned* sel = SEL + (size_t)m * TOPK;
        if (nvalid <= TOPK) {
#pragma unroll
            for (int j = 0; j < 4; ++j) { const int s = lane + 64 * j; sel[s] = s < nvalid ? (unsigned)s : 0u; }
            if (lane == 0) CNT[m] = (unsigned)nvalid;
            continue;
        }
        const int nreg = (nvalid + 63) >> 6;
        float v[64];
        if (pre) {
#pragma unroll
            for (int i = 0; i < 64; ++i) { const int s_ = i * 64 + lane; v[i] = (i < nreg && s_ < nvalid) ? ((const LAS float*)wl)[s_] : -INFINITY; }
            LDS_WAIT();
        } else tk_load(v, tk_scores(F, cur), nvalid, lane);
        pre = false;
        {
            int ns = slot + 1; TkSlot nx = cur; bool have = false;
            if (ns < nP + 2 * nS) { nx = tk_decode(ns, nP, nS, F.wave, gw, NGW); if (nx.att) { ++ns; if (ns < nP + 2 * nS) { nx = tk_decode(ns, nP, nS, F.wave, gw, NGW); have = true; } } else have = true; }
            if (have && !nx.att && nx.nvalid > TOPK) { const float* np_ = tk_scores(F, nx) + 4 * lane; const int nch = (nx.nvalid + 255) >> 8;
#pragma unroll
                for (int c = 0; c < 16; ++c) if (c < nch) __builtin_amdgcn_global_load_lds((const unsigned*)(np_ + c * 256), (LAS unsigned*)(wl + c * 1024), 16, 0, 0);
                pre = true; } }
        float mx = -INFINITY, mn = INFINITY;
#pragma unroll
        for (int i = 0; i < 64; ++i) { const int s = i * 64 + lane; const bool ok = s < nvalid; mx = fmaxf(mx, v[i]); mn = ok ? fminf(mn, v[i]) : mn; }
#pragma unroll
        for (int o = 1; o < 64; o <<= 1) { mx = fmaxf(mx, __shfl_xor(mx, o)); mn = fminf(mn, __shfl_xor(mn, o)); }
        float flo = mn, fhi = __builtin_bit_cast(float, __builtin_bit_cast(unsigned, mx) + (mx >= 0.f ? 1u : 0xffffffffu));
        if (mx == 0.f) fhi = 1e-30f;
        float tau = flo; bool exact = false;
        for (int it = 0; it < 200; ++it) {
            const float mid = 0.5f * flo + 0.5f * fhi;
            if (!(mid > flo && mid < fhi)) break;
            unsigned b0 = 0u, b1 = 0u;
#pragma unroll
            for (int blk = 0; blk < 4; ++blk) if (blk * 16 < nreg) {
#pragma unroll
                for (int i = 0; i < 16; ++i) { const int ii = blk * 16 + i; const unsigned d = __builtin_bit_cast(unsigned, v[ii] - mid);
                    if (blk < 2) b0 = __builtin_amdgcn_alignbit(b0, d, 31); else b1 = __builtin_amdgcn_alignbit(b1, d, 31); } }
            const int nproc = nreg > 48 ? 64 : (nreg > 32 ? 48 : (nreg > 16 ? 32 : 16));
            const int c = nproc * 64 - lane_count_total7(__popc(b0) + __popc(b1));
            if (c == TOPK) { tau = mid; exact = true; break; }
            if (c > TOPK) flo = mid; else fhi = mid;
            tau = flo;
        }
        int base = 0;
        const int n0 = smp ? (m - TP) >> 2 : 0;
        unsigned ptv = 0u; if (smp && lane < NPG) ptv = (unsigned)F.page_table[n0 * NPG + lane];
#pragma unroll
        for (int blk = 0; blk < 4; ++blk) if (blk * 16 < nreg) {
#pragma unroll
            for (int i = 0; i < 16; ++i) { const int ii = blk * 16 + i; const bool s_ = exact ? v[ii] >= tau : v[ii] > tau;
                const unsigned long long mk = __ballot(s_); const int pos = base + __builtin_amdgcn_mbcnt_hi((unsigned)(mk >> 32), __builtin_amdgcn_mbcnt_lo((unsigned)mk, 0u));
                if (s_) { const int s = ii * 64 + lane; unsigned e = (unsigned)s;
                    if (smp) e = s < PAST ? (unsigned)__builtin_amdgcn_readlane((int)ptv, (ii >> 1) & 15) * PAGE + (s & 127) : NEWFLAG + (unsigned)(s - PAST);
                    sel[pos] = e; }
                base += __popcll(mk); } }
        if (!exact) {
#pragma unroll
            for (int blk = 0; blk < 4; ++blk) if (blk * 16 < nreg) {
#pragma unroll
                for (int i = 0; i < 16; ++i) { const int ii = blk * 16 + i; const bool s_ = v[ii] == tau;
                    const unsigned long long mk = __ballot(s_); const int pos = base + __builtin_amdgcn_mbcnt_hi((unsigned)(mk >> 32), __builtin_amdgcn_mbcnt_lo((unsigned)mk, 0u));
                    if (s_ && pos < TOPK) { const int s = ii * 64 + lane; unsigned e = (unsigned)s;
                        if (smp) e = s < PAST ? (unsigned)__builtin_amdgcn_readlane((int)ptv, (ii >> 1) & 15) * PAGE + (s & 127) : NEWFLAG + (unsigned)(s - PAST);
                        sel[pos] = e; }
                    base += __popcll(mk); } }
        }
        if (lane == 0) CNT[m] = TOPK;
        if (smp) { VM_WAIT(); } asm volatile("" ::: "memory");
    }
}

#define AT_WAITV(n) asm volatile("s_waitcnt vmcnt(" #n ")" ::: "memory")
__device__ __forceinline__ void at_issue_tile(const char* kb, const char* vb, unsigned rstride, unsigned ilb, LAS unsigned char* ringp, int j, int lane) {
    const unsigned q = (unsigned)lane >> 3, p8 = (unsigned)lane & 7u;
    unsigned a0 = ilb + 2u * (j < 8 ? (unsigned)(32 * j) + q : (unsigned)((2 * (j - 8) + (int)(q >> 2)) * 16) + (q & 3u)); asm volatile("" : "+v"(a0));
    unsigned e0, e1, e2, e3;
    if (j < 8) asm volatile("ds_read_u16 %0, %4\n\tds_read_u16 %1, %4 offset:16\n\tds_read_u16 %2, %4 offset:32\n\tds_read_u16 %3, %4 offset:48\n\ts_waitcnt lgkmcnt(0)"
                            : "=&v"(e0), "=&v"(e1), "=&v"(e2), "=&v"(e3) : "v"(a0) : "memory");
    else       asm volatile("ds_read_u16 %0, %4\n\tds_read_u16 %1, %4 offset:8\n\tds_read_u16 %2, %4 offset:16\n\tds_read_u16 %3, %4 offset:24\n\ts_waitcnt lgkmcnt(0)"
                            : "=&v"(e0), "=&v"(e1), "=&v"(e2), "=&v"(e3) : "v"(a0) : "memory");
    const unsigned e[4] = {e0, e1, e2, e3};
#pragma unroll
    for (int i = 0; i < 4; ++i) {
        const unsigned ch = p8 ^ ((4u * (unsigned)i + (q >> 1)) & 7u);
        const char* src = (j < 8 ? kb : vb) + (e[i] * rstride + 16u * ch);
        __builtin_amdgcn_global_load_lds((const unsigned*)src, (LAS unsigned*)(ringp + (j & 3) * 4096 + i * 1024), 16, 0, 0);
    }
}
__device__ __forceinline__ long q_to_fp8(const bf16x8 qv) { const v4u w = __builtin_bit_cast(v4u, qv);
    int t = __builtin_amdgcn_cvt_pk_fp8_f32(__builtin_bit_cast(float, w.x << 16), __builtin_bit_cast(float, w.x & 0xffff0000u), 0, false);
    const unsigned lo = (unsigned)__builtin_amdgcn_cvt_pk_fp8_f32(__builtin_bit_cast(float, w.y << 16), __builtin_bit_cast(float, w.y & 0xffff0000u), t, true);
    t = __builtin_amdgcn_cvt_pk_fp8_f32(__builtin_bit_cast(float, w.z << 16), __builtin_bit_cast(float, w.z & 0xffff0000u), 0, false);
    const unsigned hi = (unsigned)__builtin_amdgcn_cvt_pk_fp8_f32(__builtin_bit_cast(float, w.w << 16), __builtin_bit_cast(float, w.w & 0xffff0000u), t, true);
    return (long)(((unsigned long long)hi << 32) | lo); }
__device__ __forceinline__ void attn_stream(Frame& F, int m0, int kvh, int count, LAS unsigned char* wl, bool sample) {
    if (count <= 0) return;
    int lane_ = fresh_lane(); asm volatile("" : "+v"(lane_));
    const int lane = lane_, r16 = lane & 15, g = lane >> 4;
    const bf16* Q = (const bf16*)(F.ws + WS_Q);
    const unsigned* SEL = sample ? (const unsigned*)(F.ws + WS_IDENT) - (size_t)m0 * TOPK : (const unsigned*)(F.ws + WS_SEL);
    const size_t pbase = (size_t)(m0 & ~(SEQ - 1));
    const char* kb = sample ? (const char*)(F.ws + WS_KC8) + ((size_t)(m0 - TP) * NKV + kvh) * (TOPK * HD) : (const char*)(F.ws + WS_K8) + pbase * KVW + kvh * HD;
    const char* vb = sample ? (const char*)(F.ws + WS_VC8) + ((size_t)(m0 - TP) * NKV + kvh) * (TOPK * HD) : (const char*)(F.ws + WS_V8) + pbase * KVW + kvh * HD;
    const unsigned rstride = sample ? (unsigned)HD : (unsigned)KVW;
    const unsigned wlb = (unsigned)(size_t)wl, ringb = wlb + 1024u;
    LAS unsigned char* ringp = wl + 1024;
    const unsigned kx = ((unsigned)r16 >> 1) & 7u;
    const unsigned kl = ringb + 128u * (unsigned)r16 + 16u * ((2u * (unsigned)g) ^ kx);
    const unsigned vr = 8u * (unsigned)g + (((unsigned)lane & 15u) >> 1), vx = (vr >> 1) & 7u;
    const unsigned vl = ringb + 128u * vr + 8u * ((unsigned)lane & 1u);
    long q8[4]; bf16x8 qn[4]; v4u seln;
    { const v4u s4 = *(const v4u*)(SEL + (size_t)m0 * TOPK + 4 * lane);
      v2u pk; pk.x = (s4.x & 0xffffu) | (s4.y << 16); pk.y = (s4.z & 0xffffu) | (s4.w << 16);
      asm volatile("ds_write_b64 %0, %1\n\ts_waitcnt lgkmcnt(0)" :: "v"(wlb + 8u * lane), "v"(pk) : "memory");
      const bf16* qp = Q + (size_t)m0 * AW + (kvh * 4 + (r16 & 3)) * HD + 8 * g;
#pragma unroll
      for (int ks = 0; ks < 4; ++ks) q8[ks] = q_to_fp8(*(const bf16x8*)(qp + 32 * ks)); }
    at_issue_tile(kb, vb, rstride, wlb, ringp, 0, lane); at_issue_tile(kb, vb, rstride, wlb, ringp, 1, lane); at_issue_tile(kb, vb, rstride, wlb, ringp, 2, lane);
    for (int k = 0; k < count; ++k) {
        const int m = m0 + k; const bool has_next = k + 1 < count;
        const unsigned ilb = wlb + 512u * (k & 1), iln = wlb + 512u * ((k + 1) & 1);
        const unsigned cnt = (!sample && (unsigned)((m & (SEQ - 1)) + 1) < (unsigned)TOPK) ? (unsigned)((m & (SEQ - 1)) + 1) : (unsigned)TOPK;
        f32x4 S[16], O[8];
#pragma unroll
        for (int c = 0; c < 8; ++c) O[c] = (f32x4){0.f, 0.f, 0.f, 0.f};
        float sum = 0.f;
#pragma clang loop unroll(full)
        for (int j = 0; j < 16; ++j) {
            if (j == 14) { if (has_next) AT_WAITV(8); else AT_WAITV(4); }
            else if (j == 15) { if (has_next) AT_WAITV(8); else AT_WAITV(0); }
            else AT_WAITV(8);
            if (j < 8) {
#pragma unroll
                for (int sub = 0; sub < 2; ++sub) {
                    unsigned ab = kl + (unsigned)(j & 3) * 4096u + 2048u * sub; asm volatile("" : "+v"(ab));
                    v4u a0, a1;
                    asm volatile("ds_read_b128 %0, %2\n\tds_read_b128 %1, %3\n\ts_waitcnt lgkmcnt(0)" : "=&v"(a0), "=&v"(a1) : "v"(ab), "v"(ab ^ 16u) : "memory");
                    f32x4 c = (f32x4){0.f, 0.f, 0.f, 0.f};
                    c = __builtin_amdgcn_mfma_f32_16x16x32_fp8_fp8((long)(((unsigned long long)a0.y << 32) | a0.x), q8[0], c, 0, 0, 0);
                    c = __builtin_amdgcn_mfma_f32_16x16x32_fp8_fp8((long)(((unsigned long long)a0.w << 32) | a0.z), q8[1], c, 0, 0, 0);
                    c = __builtin_amdgcn_mfma_f32_16x16x32_fp8_fp8((long)(((unsigned long long)a1.y << 32) | a1.x), q8[2], c, 0, 0, 0);
                    c = __builtin_amdgcn_mfma_f32_16x16x32_fp8_fp8((long)(((unsigned long long)a1.w << 32) | a1.z), q8[3], c, 0, 0, 0);
                    S[2 * j + sub] = c;
                }
                if (j == 7) {
                    constexpr float SCL = 0.08838834764831845f * 1.4426950408889634f;
                    if (cnt < (unsigned)TOPK) {
#pragma unroll
                        for (int kt = 0; kt < 16; ++kt)
#pragma unroll
                            for (int i = 0; i < 4; ++i) { const unsigned slot = kt * 16 + 4 * g + i; S[kt][i] = slot < cnt ? S[kt][i] : -INFINITY; } }
                    float mx = -INFINITY;
#pragma unroll
                    for (int kt = 0; kt < 16; ++kt)
#pragma unroll
                        for (int i = 0; i < 4; ++i) mx = fmaxf(mx, S[kt][i]);
                    mx = fmaxf(mx, __shfl_xor(mx, 16)); mx = fmaxf(mx, __shfl_xor(mx, 32));
                    const float nm = -mx * SCL;
#pragma unroll
                    for (int kt = 0; kt < 16; ++kt)
#pragma unroll
                        for (int i = 0; i < 4; ++i) { const float p = __builtin_amdgcn_exp2f(__builtin_fmaf(S[kt][i], SCL, nm)); S[kt][i] = p; sum += p; }
                    sum += __shfl_xor(sum, 16); sum += __shfl_xor(sum, 32);
                }
            } else {
                const int ks = j - 8;
                int t = __builtin_amdgcn_cvt_pk_fp8_f32(S[2 * ks][0], S[2 * ks][1], 0, false); const unsigned plo = (unsigned)__builtin_amdgcn_cvt_pk_fp8_f32(S[2 * ks][2], S[2 * ks][3], t, true);
                t = __builtin_amdgcn_cvt_pk_fp8_f32(S[2 * ks + 1][0], S[2 * ks + 1][1], 0, false); const unsigned phi = (unsigned)__builtin_amdgcn_cvt_pk_fp8_f32(S[2 * ks + 1][2], S[2 * ks + 1][3], t, true);
                const long pf = (long)(((unsigned long long)phi << 32) | plo);
                unsigned vtb = vl + (unsigned)(j & 3) * 4096u; asm volatile("" : "+v"(vtb));
                v2u b[8];
                asm volatile("ds_read_b64_tr_b8 %0, %8\n\tds_read_b64_tr_b8 %1, %9\n\tds_read_b64_tr_b8 %2, %10\n\tds_read_b64_tr_b8 %3, %11\n\t"
                             "ds_read_b64_tr_b8 %4, %12\n\tds_read_b64_tr_b8 %5, %13\n\tds_read_b64_tr_b8 %6, %14\n\tds_read_b64_tr_b8 %7, %15\n\ts_waitcnt lgkmcnt(0)"
                             : "=&v"(b[0]), "=&v"(b[1]), "=&v"(b[2]), "=&v"(b[3]), "=&v"(b[4]), "=&v"(b[5]), "=&v"(b[6]), "=&v"(b[7])
                             : "v"(vtb + 16u * (0u ^ vx)), "v"(vtb + 16u * (1u ^ vx)), "v"(vtb + 16u * (2u ^ vx)), "v"(vtb + 16u * (3u ^ vx)),
                               "v"(vtb + 16u * (4u ^ vx)), "v"(vtb + 16u * (5u ^ vx)), "v"(vtb + 16u * (6u ^ vx)), "v"(vtb + 16u * (7u ^ vx)) : "memory");
#pragma unroll
                for (int c = 0; c < 8; ++c) O[c] = __builtin_amdgcn_mfma_f32_16x16x32_fp8_fp8(pf, (long)(((unsigned long long)b[c].y << 32) | b[c].x), O[c], 0, 0, 0);
            }
            if (j == 4 && has_next) {
                seln = *(const v4u*)(SEL + (size_t)(m + 1) * TOPK + 4 * lane);
                const bf16* qp = Q + (size_t)(m + 1) * AW + (kvh * 4 + (r16 & 3)) * HD + 8 * g;
#pragma unroll
                for (int ks = 0; ks < 4; ++ks) qn[ks] = *(const bf16x8*)(qp + 32 * ks);
            }
            if (j == 12 && has_next) {
                v2u pk; pk.x = (seln.x & 0xffffu) | (seln.y << 16); pk.y = (seln.z & 0xffffu) | (seln.w << 16);
                asm volatile("ds_write_b64 %0, %1\n\ts_waitcnt lgkmcnt(0)" :: "v"(iln + 8u * lane), "v"(pk) : "memory");
            }
            if (j + 3 < 16) at_issue_tile(kb, vb, rstride, ilb, ringp, j + 3, lane);
            else if (has_next) at_issue_tile(kb, vb, rstride, iln, ringp, j + 3 - 16, lane);
        }
        float inv[4];
#pragma unroll
        for (int i = 0; i < 4; ++i) inv[i] = 1.0f / __shfl(sum, i);
        const unsigned ob = ringb + 3u * 4096u;
        if (g == 0) {
#pragma unroll
            for (int c = 0; c < 8; ++c)
#pragma unroll
                for (int i = 0; i < 4; ++i) { const unsigned hv = cvt_pk_bf16(O[c][i] * inv[i], 0.f);
                    asm volatile("ds_write_b16 %0, %1" :: "v"(ob + 2u * (unsigned)(i * HD + 16 * c + r16)), "v"(hv) : "memory"); }
        }
        v4u ov;
        asm volatile("s_waitcnt lgkmcnt(0)\n\tds_read_b128 %0, %1\n\ts_waitcnt lgkmcnt(0)" : "=&v"(ov) : "v"(ob + 16u * lane) : "memory");
        *(v4u*)((bf16*)(F.ws + WS_PA) + (size_t)m * 3072 + PW + (kvh * 4) * HD + 8 * lane) = ov;
        if (has_next) {
#pragma unroll
            for (int ks = 0; ks < 4; ++ks) q8[ks] = q_to_fp8(qn[ks]); }
    }
    AT_WAITV(0);
}
__device__ __forceinline__ void p5_attention(Frame& F) {
    const int gw = F.vcu * NWAVES + F.wave, NGW = F.G * NWAVES;
    LAS unsigned char* wl = F.lds + F.wave * AT_WAVE_LDS;
    const int per = (NB * NKV * SEQ + NGW - 1) / NGW;
    const int i0 = gw * per, i1 = (i0 + per) < NB * NKV * SEQ ? (i0 + per) : NB * NKV * SEQ;
    const int n = i1 > i0 ? i1 - i0 : 0;
    const bool streamable = (SEQ % per) == 0;
    const int step = streamable ? n : 1;
#pragma unroll 1
    for (int rep2 = 0; rep2 < PROBE_STREAM_REPS; ++rep2)
#pragma unroll 1
    for (int q = i0; q < i0 + n + 1; q += step) {
        if (q < i0 + n) attn_stream(F, ((q >> 12) >> 2) * SEQ + (q & (SEQ - 1)), (q >> 12) & 3, step, wl, false);
        else for (int idx = gw; idx < TS * NKV; idx += NGW) attn_stream(F, TP + (idx >> 2), idx & 3, 1, wl, true);
        if (q >= i0 + n) break; }
}

constexpr int NPHASE = 13;
__global__ void __launch_bounds__(NWAVES * 64, 2) fwd(Args args) {
    extern __shared__ __attribute__((aligned(16))) unsigned char lds[];
    Frame F;
    F.lds = (LAS unsigned char*)lds;
    F.tid = threadIdx.x; F.lane = F.tid & 63; F.wave = __builtin_amdgcn_readfirstlane(F.tid >> 6);
    F.G = gridDim.x; { const int bx = blockIdx.x; F.vcu = (F.G % 8 == 0) ? (bx % 8) * (F.G / 8) + bx / 8 : bx; }
    F.xp = args.in[0]; F.xs = args.in[1]; F.cache_k = args.in[2]; F.cache_v = args.in[3]; F.cache_ik = args.in[4]; F.state_pool = args.in[5];
    F.cp = args.in[7]; F.cs = args.in[8]; F.w_ada = args.in[9]; F.b_ada = args.in[10]; F.g1 = args.in[11]; F.w_in = args.in[12]; F.w_grp = args.in[13]; F.pool_scale = args.in[14];
    F.w_up_pool = args.in[15]; F.w_up_attn = args.in[16]; F.w_out = args.in[17]; F.g2 = args.in[18]; F.w_ffn_in = args.in[19]; F.w_ffn_out = args.in[20]; F.g_final = args.in[21];
    F.page_table = args.page_table; F.out = args.out; F.ws = args.ws;
    volatile LAS unsigned* MISC = (volatile LAS unsigned*)(F.lds + MISC_OFF);
    for (int u = F.tid; u < (LDS_BYTES - MISC_OFF) / 4; u += NWAVES * 64) MISC[u] = 0u;
    __syncthreads();
    unsigned* ctl = (unsigned*)(F.ws + WS_CTL);
    XcdBarrier bar; bar.bar = ctl + CW_BAR; bar.x = 0; bar.st = nullptr;
    if (!MK_MULTI) bar = xcd_barrier_post(ctl + CW_BAR, MISC + 8, F.tid == 0);
    const int lo = args.ph_lo, hi = args.ph_hi;
#ifndef PH_MASK
#define PH_MASK 0x1fff
#endif

#ifndef DUP_MASK
#define DUP_MASK 0
#endif
#define IN(k) (((PH_MASK >> (k)) & 1) && lo <= (k) && (k) < hi)
#define REP(k) for (int rep_ = 0; rep_ < (((DUP_MASK >> (k)) & 1) ? 2 : 1); ++rep_)
#define FRESH() do { int l_ = fresh_lane(); asm volatile("" : "+v"(l_)); F.lane = l_; F.tid = F.wave * 64 + l_; } while (0)
#define SEAM(k) do { if (IN(k) && IN((k) + 1)) { FRESH(); xcd_barrier(bar, F.tid == 0); } FRESH(); } while (0)
    const int gw = F.vcu * NWAVES + F.wave, NGW = F.G * NWAVES;
    float* MODS = (float*)(F.ws + WS_MODS); bf16* U = (bf16*)(F.ws + WS_U); float* H = (float*)(F.ws + WS_H);

    if (IN(0)) REP(0) { p0_prologue(F); } SEAM(0);
    if (IN(1)) REP(1) { p1_adaln(F); } SEAM(1);
    if (IN(2)) REP(2) {
        f32x4 cur[8], nx[8];
        if (gw < MR) row_load(cur, xrow_of(F, gw), F.lane);
        for (int m = gw; m < MR; m += NGW) { const bool more = m + NGW < MR;
            if (more) row_load(nx, xrow_of(F, m + NGW), F.lane);
            const float* md = MODS + (size_t)bidx_of(m) * NADA; row_store_mod(cur, row_rstd(cur), F.g1, md, md + D, U + (size_t)m * D, F.lane);
            if (more) {
#pragma unroll
                for (int j = 0; j < 8; ++j) cur[j] = nx[j]; } }
    } SEAM(2);
    if (IN(3)) REP(3) {
        pg8::Gemm g{U, (const bf16*)(F.ws + WS_W1T)}; pg8::StaticOrder S; S.init(MR, N1, F.G, (int)blockIdx.x);
        EpiIn E{0, F.out, (float*)(F.ws + WS_PIN), (bf16*)(F.ws + WS_Q), (bf16*)(F.ws + WS_KB), (bf16*)(F.ws + WS_VB), (bf16*)(F.ws + WS_QI), (bf16*)(F.ws + WS_GA), (bf16*)(F.ws + WS_GB), (bf16*)(F.ws + WS_KI), (float*)(F.ws + WS_WI), F.ws + WS_K8, F.ws + WS_V8};
        pg8::gemm_phase<EpiIn, pg8::Shape<D, D, D, 0>>(F.lds, g, S, E, F.wave, F.lane);
    } SEAM(3);
    if (IN(4)) REP(4) { p3_pool_d(F); FRESH(); p3_indexer(F); } SEAM(4);
    if (IN(5)) REP(5) {
        pg8::Gemm g{(const bf16*)(F.ws + WS_DG), (const bf16*)(F.ws + WS_WGT)}; pg8::StaticOrder S; S.init(MR, PW, F.G, (int)blockIdx.x);
        EpiPool E{0, (bf16*)(F.ws + WS_PA), F.pool_scale};
        pg8::gemm_phase<EpiPool, pg8::Shape<PG, PG, PG, (size_t)MR * PG * 2>>(F.lds, g, S, E, F.wave, F.lane);
        FRESH(); p4_topk(F);
    } SEAM(5);
    if (IN(6)) REP(6) { p5_attention(F); } SEAM(6);
    float* SLAB_A = (float*)(F.ws + WS_SCP); float* SLAB_B = (float*)(F.ws + WS_SCP + 64 * MiB);
    if (IN(7)) REP(7) {
        pg8::StaticOrder S; S.init(TP, D, F.G, (int)blockIdx.x);
        { pg8::Gemm g{(const bf16*)(F.ws + WS_PA), (const bf16*)(F.ws + WS_WUPT)};
          EpiMixFused E{0, (const bf16*)(F.ws + WS_GA), (const bf16*)(F.ws + WS_GB), (bf16*)(F.ws + WS_MIX)};
          pg8::gemm_phase<EpiMixFused, pg8::Shape<3072, 3072, 3072, 0>>(F.lds, g, S, E, F.wave, F.lane); }
        { pg8::Gemm g{(const bf16*)(F.ws + WS_PA), (const bf16*)(F.ws + WS_WUPT)}; pg8::SplitOrder SS{TP / 256, TS / 256, D / 256, 12, F.G, (int)blockIdx.x};
          EpiSlab<true> E{0, SLAB_A, (const bf16*)(F.ws + WS_GA), (const bf16*)(F.ws + WS_GB), 4};
          pg8::gemm_phase<EpiSlab<true>, pg8::Shape<256, 3072, 3072, 0>, pg8::SplitOrder>(F.lds, g, SS, E, F.wave, F.lane); }
    } SEAM(7);
    if (IN(8)) REP(8) {
        for (int i = gw * 64 + F.lane; i < TS * D / 4; i += NGW * 64) { f32x4 a = (f32x4){0.f, 0.f, 0.f, 0.f};
#pragma unroll
            for (int sidx = 0; sidx < 12; ++sidx) a += *(const f32x4*)(SLAB_A + (size_t)sidx * TS * D + (size_t)i * 4);
            v2u w; w.x = cvt_pk_bf16(a.x, a.y); w.y = cvt_pk_bf16(a.z, a.w); *(v2u*)((bf16*)(F.ws + WS_MIX) + (size_t)TP * D + (size_t)i * 4) = w; }
        { pg8::Gemm g{(const bf16*)(F.ws + WS_MIX), (const bf16*)(F.ws + WS_WOUTT)}; pg8::StaticOrder S; S.init(TP, D, F.G, (int)blockIdx.x);
          EpiRes E{0, F.xp, F.xs, H, MODS, 2 * D};
          pg8::gemm_phase<EpiRes, pg8::Shape<D, D, D, 0>>(F.lds, g, S, E, F.wave, F.lane); }
        if (!MK_MULTI) { FRESH(); xcd_barrier(bar, F.tid == 0); FRESH(); }
        { pg8::Gemm g{(const bf16*)(F.ws + WS_MIX), (const bf16*)(F.ws + WS_WOUTT)}; pg8::SplitOrder SS{TP / 256, TS / 256, D / 256, 8, F.G, (int)blockIdx.x};
          EpiSlab<false> E{0, SLAB_B, nullptr, nullptr, 0};
          pg8::gemm_phase<EpiSlab<false>, pg8::Shape<256, D, D, 0>, pg8::SplitOrder>(F.lds, g, SS, E, F.wave, F.lane); }
    } SEAM(8);
    if (IN(9)) REP(9) {
        f32x4 cur[8], nx[8];
        if (gw < TP) row_load(cur, H + (size_t)gw * D, F.lane);
        { LAS float* red = (LAS float*)F.lds; int par = 0;
          for (int r = F.vcu; r < TS; r += F.G, par ^= 1) { const int m = TP + r; const float* md = MODS + (size_t)bidx_of(m) * NADA; float rstd;
            const f32x4 v = coop_row<8>(F, F.xs + (size_t)r * D, SLAB_B + (size_t)r * D, md + 2 * D, red + 8 * par, rstd);
            const int c = 256 * F.wave + 4 * F.lane; *(f32x4*)(H + (size_t)m * D + c) = v;
            const f32x4 gg = *(const f32x4*)(F.g2 + c), sh = *(const f32x4*)(md + 3 * D + c), sc = *(const f32x4*)(md + 4 * D + c);
            const f32x4 o = (v * rstd * gg) * (sc + 1.0f) + sh;
            v2u w; w.x = cvt_pk_bf16(o.x, o.y); w.y = cvt_pk_bf16(o.z, o.w); *(v2u*)(U + (size_t)m * D + c) = w; } }
        for (int m = gw; m < TP; m += NGW) { const bool more = m + NGW < TP;
            if (more) row_load(nx, H + (size_t)(m + NGW) * D, F.lane);
            const float* md = MODS + (size_t)bidx_of(m) * NADA; row_store_mod(cur, row_rstd(cur), F.g2, md + 3 * D, md + 4 * D, U + (size_t)m * D, F.lane);
            if (more) {
#pragma unroll
                for (int j = 0; j < 8; ++j) cur[j] = nx[j]; } }
        __syncthreads();
    } SEAM(9);
    if (IN(10)) REP(10) {
        pg8::Gemm g{U, (const bf16*)(F.ws + WS_WFIT)}; pg8::StaticOrder S; S.init(MR, 2 * DFF, F.G, (int)blockIdx.x);
        EpiFfn E{0, (bf16*)(F.ws + WS_ACT)};
        pg8::gemm_phase<EpiFfn, pg8::Shape<D, D, D, 0>>(F.lds, g, S, E, F.wave, F.lane);
    } SEAM(10);
    if (IN(11)) {
        { pg8::Gemm g{(const bf16*)(F.ws + WS_ACT), (const bf16*)(F.ws + WS_WFOT)}; pg8::StaticOrder S; S.init(TP, D, F.G, (int)blockIdx.x);
          EpiRes E{0, H, H + (size_t)TP * D, H, MODS, 5 * D};
          pg8::gemm_phase<EpiRes, pg8::Shape<DFF, DFF, DFF, 0>>(F.lds, g, S, E, F.wave, F.lane); }
        { pg8::Gemm g{(const bf16*)(F.ws + WS_ACT), (const bf16*)(F.ws + WS_WFOT)}; pg8::SplitOrder SS{TP / 256, TS / 256, D / 256, 11, F.G, (int)blockIdx.x};
          EpiSlab<false> E{0, SLAB_A, nullptr, nullptr, 0};
          pg8::gemm_phase<EpiSlab<false>, pg8::Shape<512, DFF, DFF, 0>, pg8::SplitOrder>(F.lds, g, SS, E, F.wave, F.lane); }
    } SEAM(11);
    if (IN(12)) REP(12) {
        f32x4 cur[8], nx[8];
        if (gw < TP) row_load(cur, H + (size_t)gw * D, F.lane);
        { LAS float* red = (LAS float*)F.lds; int par = 0;
          for (int r = F.vcu; r < TS; r += F.G, par ^= 1) { const int m = TP + r; float rstd;
            const f32x4 v = coop_row<11>(F, H + (size_t)m * D, SLAB_A + (size_t)r * D, MODS + (size_t)bidx_of(m) * NADA + 5 * D, red + 8 * par, rstd);
            const int c = 256 * F.wave + 4 * F.lane; *(f32x4*)(F.out + OUT_Y + (size_t)m * D + c) = v * rstd * *(const f32x4*)(F.g_final + c); } }
        for (int m = gw; m < TP; m += NGW) { const bool more = m + NGW < TP;
            if (more) row_load(nx, H + (size_t)(m + NGW) * D, F.lane);
            row_store_final(cur, row_rstd(cur), F.g_final, F.out + OUT_Y + (size_t)m * D, F.lane);
            if (more) {
#pragma unroll
                for (int j = 0; j < 8; ++j) cur[j] = nx[j]; } }
    }
#undef IN
#undef SEAM
}

extern "C" void kernel_launch(void* const* d_in, const int* in_sizes, int n_in, void* d_out, int out_size, void* d_ws, size_t ws_size, hipStream_t stream) {
    static int grid = 0;
    if (grid == 0) {
        if (n_in != 22 || (size_t)out_size != OUT_END || ws_size < WS_END) { fprintf(stderr, "kernel_launch: unexpected shapes (n_in %d, out %d, ws %zu, need %zu)\n", n_in, out_size, ws_size, (size_t)WS_END); grid = -1; return; }
        int dev = 0, cus = 0, per_cu = 0;
        if (hipGetDevice(&dev) != hipSuccess || hipDeviceGetAttribute(&cus, hipDeviceAttributeMultiprocessorCount, dev) != hipSuccess) { grid = -1; return; }
        if (hipFuncSetAttribute((const void*)fwd, hipFuncAttributeMaxDynamicSharedMemorySize, LDS_BYTES) != hipSuccess) { fprintf(stderr, "kernel_launch: hipFuncSetAttribute failed\n"); grid = -1; return; }
        if (hipOccupancyMaxActiveBlocksPerMultiprocessor(&per_cu, (const void*)fwd, NWAVES * 64, LDS_BYTES) != hipSuccess || per_cu < 1) fprintf(stderr, "kernel_launch: occupancy query says %d\n", per_cu);
        (void)hipGetLastError();
        grid = cus;
    }
    if (grid < 0) return;
    (void)hipMemsetAsync((char*)d_ws + WS_CTL, 0, CTL_ZERO_BYTES, stream);
    Args a{};
    for (int i = 0; i < 22; ++i) a.in[i] = (const float*)d_in[i];
    a.page_table = (const int*)d_in[6]; a.out = (float*)d_out; a.ws = (unsigned char*)d_ws;
#if MK_MULTI
    for (int p = 0; p < NPHASE; ++p) { a.ph_lo = p; a.ph_hi = p + 1; hipLaunchKernelGGL(fwd, dim3(grid), dim3(NWAVES * 64), LDS_BYTES, stream, a); }
#else
    a.ph_lo = 0; a.ph_hi = NPHASE; hipLaunchKernelGGL(fwd, dim3(grid), dim3(NWAVES * 64), LDS_BYTES, stream, a);
#endif
    const hipError_t le = hipPeekAtLastError();
    if (le != hipSuccess) fprintf(stderr, "kernel_launch: launch failed: %s\n", hipGetErrorName(le));
}
```

```cpp
#include <hip/hip_runtime.h>
#include <cstdio>
#include <cstdint>

#ifndef PROBE_STREAM_REPS
#define PROBE_STREAM_REPS 1
#endif
#ifndef MK_MULTI
#define MK_MULTI 0
#endif

namespace pg8 {
#define PG8_LAS __attribute__((address_space(3)))
typedef unsigned short bf16_t;
typedef short bf16x8 __attribute__((ext_vector_type(8)));
typedef float f32x4 __attribute__((ext_vector_type(4)));
typedef unsigned u32x4 __attribute__((ext_vector_type(4)));
typedef unsigned u32x2 __attribute__((ext_vector_type(2)));
constexpr int BM = 256, BK = 64, HALF = 128, HTB = HALF * BK * 2, STAGE_BYTES = 8 * HTB, NXCD = 8, WGM = 8;

__host__ __device__ __forceinline__ int lds_byte(int r, int c) { const int st = (r >> 4) * 2 + (c >> 5), rr = r & 15, cc = c & 31, ob = rr * 64 + cc * 2; return st * 1024 + (ob ^ (((ob >> 9) & 1) << 5)); }
__host__ __device__ __forceinline__ void stage_rc(int b, int& R, int& C) { const int st = b / 1024, sb = b % 1024, swz = sb ^ (((sb >> 9) & 1) << 5); R = (st >> 1) * 16 + swz / 64; C = (st & 1) * 32 + (swz % 64) / 2; }
__host__ __device__ __forceinline__ int perm32(int rho) { const int n = rho >> 4, i = rho & 15; return 8 * (i >> 2) + 4 * n + (i & 3); }

struct Unit { int pm, pn, ks; };
struct Gemm { const bf16_t* A; const bf16_t* Bt; };
template <int K_, int LDA_, int LDB_, size_t APN_> struct Shape { static constexpr int K = K_, LDA = LDA_, LDB = LDB_; static constexpr size_t APN = APN_; };
struct SplitOrder {
    int pm0, npm, nN, nks, G, c;
    __host__ __device__ bool next(int i, Unit& u) const { const int L = i * G + c; if (L >= npm * nN * nks) return false; u.pm = pm0 + L % npm; u.pn = (L / npm) % nN; u.ks = L / (npm * nN); return true; }
};

struct StaticOrder {
    int nM, nN, nwg, G, c;
    __host__ __device__ void init(int M, int N, int G_, int c_) { nM = M / BM; nN = N / BM; nwg = nM * nN; G = G_; c = c_; }
    __host__ __device__ bool next(int i, Unit& u) const {
        const long L = (long)i * G + c; if (L >= nwg) return false;
        int wgid = (int)L; { const int q = nwg / NXCD, r = nwg % NXCD, xcd = wgid % NXCD, off = wgid / NXCD; wgid = (xcd < r ? xcd * (q + 1) : r * (q + 1) + (xcd - r) * q) + off; }
        const int nig = WGM * nN, gid = wgid / nig, fm = gid * WGM, gsz = (nM - fm) < WGM ? (nM - fm) : WGM;
        u.pm = fm + ((wgid % nig) % gsz); u.pn = (wgid % nig) / gsz; u.ks = 0; return true;
    }
};

typedef __bf16 bf16x2_n __attribute__((ext_vector_type(2)));
typedef float f32x2_n __attribute__((ext_vector_type(2)));
__device__ __forceinline__ unsigned cvt_pk_bf16(float lo, float hi) { const f32x2_n v = {lo, hi}; return __builtin_bit_cast(unsigned, __builtin_convertvector(v, bf16x2_n)); }

template <class Epi, class SH, class Sched = StaticOrder, bool ALIGN_EPI = true>
__device__ __forceinline__ void gemm_phase(PG8_LAS unsigned char* lds, const Gemm g, const Sched& S, const Epi& E, const int wid, const int lane) {
    const int tid = wid * 64 + lane, wr = wid >> 2, wc = wid & 3, fr = lane & 15, fq = lane >> 4;
    constexpr int K = SH::K, nt = K / BK; static_assert(K % 128 == 0 && K >= 256, "K");
    unsigned voffA[2], voffB[2];
#pragma unroll
    for (int i = 0; i < 2; ++i) { int R, C; stage_rc(tid * 16 + i * 8192, R, C); const int Rb = Epi::PERM ? ((R & ~31) + perm32(R & 31)) : R;
        voffA[i] = (unsigned)(R * SH::LDA + C) * 2u; voffB[i] = (unsigned)(Rb * SH::LDB + C) * 2u; }
    constexpr size_t kstep = (size_t)(BK * 2);
    constexpr size_t hA = (size_t)HALF * SH::LDA * 2, hB = (size_t)HALF * SH::LDB * 2;
    constexpr size_t tA = 2 * hA, tB = 2 * hB;
    const unsigned ldsw = (unsigned)wid * 1024u;
    const int aoff = lds_byte(wr * 64 + fr, fq * 8), boff = lds_byte(wc * 32 + fr, fq * 8);
#define PG8_SA(b, h) (((b) * 2 + (h)) * HTB)
#define PG8_SB(b, h) ((4 + (b) * 2 + (h)) * HTB)
#define PG8_STAGE(bufoff, gbase, voff) do { _Pragma("unroll") for (int _i = 0; _i < 2; ++_i) \
        __builtin_amdgcn_global_load_lds((const unsigned*)((const char*)(gbase) + (voff)[_i]), (PG8_LAS unsigned*)(lds + (bufoff) + ldsw + _i * 8192), 16, 0, 0); } while (0)
#define PG8_LDA(dst, b, h) do { _Pragma("unroll") for (int m = 0; m < 4; ++m) _Pragma("unroll") for (int k = 0; k < 2; ++k) dst[m][k] = *(const PG8_LAS bf16x8*)(lds + PG8_SA(b, h) + aoff + m * 2048 + k * 1024); } while (0)
#define PG8_LDB(dst, b, h) do { _Pragma("unroll") for (int n = 0; n < 2; ++n) _Pragma("unroll") for (int k = 0; k < 2; ++k) dst[n][k] = *(const PG8_LAS bf16x8*)(lds + PG8_SB(b, h) + boff + n * 2048 + k * 1024); } while (0)
#define PG8_MMA(ai, bj, At, Bt) do { __builtin_amdgcn_s_setprio(1); _Pragma("unroll") for (int m = 0; m < 4; ++m) _Pragma("unroll") for (int n = 0; n < 2; ++n) _Pragma("unroll") for (int k = 0; k < 2; ++k) \
        acc[ai][bj][m][n] = __builtin_amdgcn_mfma_f32_16x16x32_bf16(Bt[n][k], At[m][k], acc[ai][bj][m][n], 0, 0, 0); __builtin_amdgcn_s_setprio(0); } while (0)
#define PG8_WAIT_V(n) asm volatile("s_waitcnt vmcnt(" #n ")" ::: "memory")
#define PG8_WAIT_L(n) asm volatile("s_waitcnt lgkmcnt(" #n ")" ::: "memory")
#define PG8_BAR __builtin_amdgcn_s_barrier()
#define PG8_SCHED __builtin_amdgcn_sched_barrier(0)
#define PG8_KTILES(T0, T1) do { \
        _Pragma("nounroll") for (int t = (T0); t < (T1); t += 2) { \
            const bool last = (t == nt - 2); \
            const char* a1 = cA + (size_t)(t + 1) * kstep; \
            const char* a2 = last ? nA : cA + (size_t)(t + 2) * kstep; const char* b2 = last ? nB : cB + (size_t)(t + 2) * kstep; \
            const char* a3 = a2 + kstep; const char* b3 = b2 + kstep; \
            PG8_LDB(B0, 0, 0); PG8_LDB(B1, 0, 1); PG8_SCHED; PG8_LDA(At, 0, 0); PG8_STAGE(PG8_SA(1, 1), a1 + hA, voffA); \
            PG8_WAIT_V(8); PG8_WAIT_L(0); PG8_BAR; PG8_MMA(0, 0, At, B0); PG8_MMA(0, 1, At, B1); PG8_BAR; PG8_SCHED; \
            PG8_LDA(At, 0, 1); PG8_STAGE(PG8_SB(0, 0), b2, voffB); PG8_STAGE(PG8_SB(0, 1), b2 + hB, voffB); PG8_STAGE(PG8_SA(0, 0), a2, voffA); \
            PG8_WAIT_V(8); PG8_WAIT_L(0); PG8_BAR; PG8_MMA(1, 0, At, B0); PG8_MMA(1, 1, At, B1); PG8_BAR; PG8_SCHED; \
            PG8_LDB(B0, 1, 0); PG8_LDB(B1, 1, 1); PG8_SCHED; PG8_LDA(At, 1, 0); PG8_STAGE(PG8_SA(0, 1), a2 + hA, voffA); \
            PG8_WAIT_V(8); PG8_WAIT_L(0); PG8_BAR; PG8_MMA(0, 0, At, B0); PG8_MMA(0, 1, At, B1); PG8_BAR; PG8_SCHED; \
            PG8_LDA(At, 1, 1); PG8_STAGE(PG8_SB(1, 0), b3, voffB); PG8_STAGE(PG8_SB(1, 1), b3 + hB, voffB); PG8_STAGE(PG8_SA(1, 0), a3, voffA); \
            PG8_WAIT_V(8); PG8_WAIT_L(0); PG8_BAR; PG8_MMA(1, 0, At, B0); PG8_MMA(1, 1, At, B1); PG8_BAR; PG8_SCHED; \
        } \
    } while (0)
    Unit cur, nxt; int ui = 0;
    if (!S.next(0, cur)) return;
    f32x4 acc[2][2][4][2];
#pragma unroll
    for (int a = 0; a < 2; ++a)
#pragma unroll
        for (int b = 0; b < 2; ++b)
#pragma unroll
            for (int m = 0; m < 4; ++m)
#pragma unroll
                for (int n = 0; n < 2; ++n) acc[a][b][m][n] = (f32x4){0.f, 0.f, 0.f, 0.f};
    bf16x8 At[4][2], B0[2][2], B1[2][2];
    constexpr size_t ksb = (size_t)K * 2;
    const char* cA = (const char*)g.A + (size_t)cur.pm * tA + (size_t)cur.pn * SH::APN + (size_t)cur.ks * ksb; const char* cB = (const char*)g.Bt + (size_t)cur.pn * tB + (size_t)cur.ks * ksb;
    PG8_STAGE(PG8_SB(0, 0), cB, voffB); PG8_STAGE(PG8_SB(0, 1), cB + hB, voffB); PG8_STAGE(PG8_SA(0, 0), cA, voffA); PG8_STAGE(PG8_SA(0, 1), cA + hA, voffA);
    if (wr == 1) PG8_BAR;
    PG8_WAIT_V(2); PG8_BAR;
    PG8_STAGE(PG8_SB(1, 0), cB + kstep, voffB); PG8_STAGE(PG8_SA(1, 0), cA + kstep, voffA); PG8_STAGE(PG8_SB(1, 1), cB + hB + kstep, voffB);
    PG8_WAIT_V(6); PG8_BAR;
    for (;;) {
        const bool has_next = S.next(ui + 1, nxt);
        const char* nA = has_next ? (const char*)g.A + (size_t)nxt.pm * tA + (size_t)nxt.pn * SH::APN + (size_t)nxt.ks * ksb : cA; const char* nB = has_next ? (const char*)g.Bt + (size_t)nxt.pn * tB + (size_t)nxt.ks * ksb : cB;
        if constexpr (Epi::HAS_MID) { PG8_KTILES(0, Epi::MID_T); E.mid(acc, cur, wr, wc, fr, fq); PG8_KTILES(Epi::MID_T, nt); } else { PG8_KTILES(0, nt); }
        if constexpr (ALIGN_EPI) { if (wr == 0) PG8_BAR; }
        E(acc, cur, wr, wc, fr, fq);
        if (!has_next) break;
#pragma unroll
        for (int a = 0; a < 2; ++a)
#pragma unroll
            for (int b = 0; b < 2; ++b)
#pragma unroll
                for (int m = 0; m < 4; ++m)
#pragma unroll
                    for (int n = 0; n < 2; ++n) acc[a][b][m][n] = (f32x4){0.f, 0.f, 0.f, 0.f};
        cur = nxt; cA = nA; cB = nB; ++ui;
        if constexpr (ALIGN_EPI) { if (wr == 1) PG8_BAR; }
    }
    PG8_WAIT_V(0);
    if constexpr (!ALIGN_EPI) { if (wr == 0) PG8_BAR; }
    PG8_BAR;
#undef PG8_SA
#undef PG8_SB
#undef PG8_STAGE
#undef PG8_LDA
#undef PG8_LDB
#undef PG8_MMA
#undef PG8_WAIT_V
#undef PG8_WAIT_L
#undef PG8_BAR
#undef PG8_SCHED
#undef PG8_KTILES
}
}

constexpr int D = 2048, SEQ = 4096, NB = 2, TP = NB * SEQ, NSEQ = 128, DSEQ = 4, TS = NSEQ * DSEQ, MR = TP + TS;
constexpr int PAST = 2048, PAGE = 128, NPG = PAST / PAGE, NPHYS = 2560;
constexpr int PW = 1024, PG = 256, PBUF = 15;
constexpr int HD = 128, NH = 16, NKV = 4, AW = 2048, KVW = 512;
constexpr int NIH = 16, IDD = 64, QIW = 1024, TOPK = 256;
constexpr int DFF = 5632, NADA = 6 * D, NCOND = NB + NSEQ;
constexpr int INW = 9296, N1 = 9472;
constexpr float EPS = 1e-6f;
constexpr int SKEYS = PAST + DSEQ, SC_S_LD = 2112;
constexpr unsigned NEWFLAG = 1u << 30;
static_assert(MR % 256 == 0 && N1 % 256 == 0 && DFF % 128 == 0, "tiles");

constexpr size_t OUT_Y = 0, OUT_KP = (size_t)MR * D, OUT_VP = OUT_KP + (size_t)TP * KVW, OUT_IKP = OUT_VP + (size_t)TP * KVW, OUT_PP = OUT_IKP + (size_t)TP * IDD,
                 OUT_KS = OUT_PP + (size_t)NB * PBUF * PW, OUT_VS = OUT_KS + (size_t)TS * KVW, OUT_IKS = OUT_VS + (size_t)TS * KVW, OUT_PS = OUT_IKS + (size_t)TS * IDD,
                 OUT_END = OUT_PS + (size_t)NSEQ * PBUF * PW;
static_assert(OUT_END == 29292544, "output size");

constexpr size_t MiB = 1u << 20;
constexpr size_t al(size_t x) { return (x + MiB - 1) / MiB * MiB; }
constexpr size_t WS_CTL = 0, CTL_ZERO_BYTES = MiB;
constexpr size_t WS_W1T = WS_CTL + MiB;
constexpr size_t WS_WUPT = WS_W1T + al((size_t)N1 * D * 2);
constexpr size_t WS_WOUTT = WS_WUPT + al((size_t)D * 3072 * 2);
constexpr size_t WS_WFIT = WS_WOUTT + al((size_t)D * D * 2);
constexpr size_t WS_WFOT = WS_WFIT + al((size_t)2 * DFF * D * 2);
constexpr size_t WS_WGT = WS_WFOT + al((size_t)D * DFF * 2);
constexpr size_t WS_SC = WS_WGT + al((size_t)PW * PG * 2);
constexpr size_t WS_MODS = WS_SC + al((size_t)144 * D * 2);
constexpr size_t WS_U = WS_MODS + al((size_t)NCOND * NADA * 4);
constexpr size_t WS_PIN = WS_U + al((size_t)MR * D * 2);
constexpr size_t WS_Q = WS_PIN + al((size_t)MR * PW * 4);
constexpr size_t WS_KB = WS_Q + al((size_t)MR * AW * 2);
constexpr size_t WS_VB = WS_KB + al((size_t)MR * KVW * 2);
constexpr size_t WS_QI = WS_VB + al((size_t)MR * KVW * 2);
constexpr size_t WS_KI = WS_QI + al((size_t)MR * QIW * 2);
constexpr size_t WS_WI = WS_KI + al((size_t)MR * IDD * 2);
constexpr size_t WS_GA = WS_WI + al((size_t)MR * NIH * 4);
constexpr size_t WS_GB = WS_GA + al((size_t)MR * D * 2);
constexpr size_t WS_DG = WS_GB + al((size_t)MR * D * 2);
constexpr size_t WS_PA = WS_DG + al((size_t)MR * PW * 2);
constexpr size_t WS_MIX = WS_PA + al((size_t)MR * 3072 * 2);
constexpr size_t WS_H = WS_MIX + al((size_t)MR * D * 2);
constexpr size_t WS_ACT = WS_H + al((size_t)MR * D * 4);
constexpr size_t WS_SCP = WS_ACT + al((size_t)MR * DFF * 2);
constexpr size_t WS_SCS = WS_SCP + al((size_t)TP * SEQ * 4);
constexpr size_t WS_SEL = WS_SCS + al((size_t)TS * SC_S_LD * 4);
constexpr size_t WS_CNT = WS_SEL + al((size_t)MR * TOPK * 4);
constexpr size_t WS_K8 = WS_CNT + al((size_t)MR * 4);
constexpr size_t WS_V8 = WS_K8 + al((size_t)TP * KVW);
constexpr size_t WS_KC8 = WS_V8 + al((size_t)TP * KVW);
constexpr size_t WS_VC8 = WS_KC8 + al((size_t)TS * NKV * TOPK * HD);
constexpr size_t WS_IDENT = WS_VC8 + al((size_t)TS * NKV * TOPK * HD);
constexpr size_t WS_END = WS_IDENT + MiB;

constexpr int CW_BAR = 4096;
constexpr int NWAVES = 8;
constexpr int LDS_BYTES = 147456;
constexpr int MISC_OFF = 143360;

#define GAS __attribute__((address_space(1)))
#define LAS __attribute__((address_space(3)))
typedef unsigned short bf16;
typedef unsigned v4u __attribute__((ext_vector_type(4)));
typedef unsigned v2u __attribute__((ext_vector_type(2)));
typedef float f32x4 __attribute__((ext_vector_type(4)));
typedef float f32x16 __attribute__((ext_vector_type(16)));
typedef short bf16x8 __attribute__((ext_vector_type(8)));
typedef unsigned short u16x4 __attribute__((ext_vector_type(4)));
#define LDS_WAIT() asm volatile("s_waitcnt lgkmcnt(0)" ::: "memory")
#define VM_WAIT() asm volatile("s_waitcnt vmcnt(0)" ::: "memory")
using pg8::cvt_pk_bf16;
__device__ __forceinline__ float bf2f(unsigned short b) { return __builtin_bit_cast(float, (unsigned)b << 16); }
__device__ __forceinline__ float sigmoidf_(float x) { return __builtin_amdgcn_rcpf(1.0f + __builtin_amdgcn_exp2f(-1.44269504f * x)); }
__device__ __forceinline__ float siluf_(float x) { return x * sigmoidf_(x); }
__device__ __forceinline__ float relu_(float x) { const int b = __builtin_bit_cast(int, x); return __builtin_bit_cast(float, b > 0 ? b : 0); }

__device__ __forceinline__ int fresh_lane() { unsigned ones = ~0u; asm volatile("" : "+v"(ones)); return (int)__builtin_amdgcn_mbcnt_hi(ones, __builtin_amdgcn_mbcnt_lo(ones, 0u)); }
#define XB_TMO      128
#define XB_XCNT(j)  (256  + 64 * (j))
#define XB_XSUB(j)  (1280 + 64 * (j))
#define XB_XGEN(j)  (2304 + 64 * (j))
#define XB_TOP      3328
#define XB_TOPGEN   3392
#define XCD_BAR_WORDS 3456
#define XB_SPIN_CAP (1u << 18)
__device__ __forceinline__ unsigned xb_ld(unsigned* p)              { return __hip_atomic_load(p, __ATOMIC_RELAXED, __HIP_MEMORY_SCOPE_AGENT); }
__device__ __forceinline__ unsigned xb_add(unsigned* p, unsigned v) { return __hip_atomic_fetch_add(p, v, __ATOMIC_RELAXED, __HIP_MEMORY_SCOPE_AGENT); }
__device__ __forceinline__ unsigned xb_xcc_id() { return (unsigned)__builtin_amdgcn_s_getreg((3 << 11) | 20) & 0xFu; }
#define XB_SPIN(cond, bar) do { unsigned _sp = 0; while (cond) {   \
    if ((++_sp & 255u) == 0u) { if (xb_ld(&(bar)[XB_TMO])) break; if (_sp > XB_SPIN_CAP) { atomicAdd(&(bar)[XB_TMO], 1u); break; } } } } while (0)
struct XcdBarrier { unsigned* bar; unsigned x; volatile LAS unsigned* st; };
__device__ __forceinline__ XcdBarrier xcd_barrier_post(unsigned* bar, volatile LAS unsigned* st, bool leader) {
    XcdBarrier b; b.bar = bar; b.x = xb_xcc_id(); b.st = st;
    if (leader) (void)xb_add(&bar[XB_XCNT(b.x)], 1u);
    return b;
}
__device__ __forceinline__ void xcd_barrier_complete(unsigned* bar, unsigned x, unsigned& nloc, unsigned& nx) {
    const unsigned G = gridDim.x * gridDim.y * gridDim.z;
    unsigned sum, cnt, mine, sp = 0u;
    for (;;) {
        sum = 0u; cnt = 0u; mine = 0u;
#pragma unroll
        for (unsigned j = 0; j < 16; ++j) { const unsigned c = xb_ld(&bar[XB_XCNT(j)]); sum += c; cnt += (c > 0u) ? 1u : 0u; mine = (j == x) ? c : mine; }
        if (sum == G) break;
        __builtin_amdgcn_s_sleep(1);
        if ((++sp & 255u) == 0u) { if (xb_ld(&bar[XB_TMO])) break; if (sp > XB_SPIN_CAP) { atomicAdd(&bar[XB_TMO], 1u); break; } }
    }
    nloc = mine > 0u ? mine : 1u; nx = cnt > 0u ? cnt : 1u;
}
__device__ __forceinline__ void xcd_barrier(const XcdBarrier& b, bool leader) {
    asm volatile("s_waitcnt vmcnt(0)" ::: "memory");
    __syncthreads();
    if (leader) {
        unsigned* bar = b.bar;
        __builtin_amdgcn_s_waitcnt(0);
        unsigned nloc = b.st[0], nx = b.st[1];
        if (nloc == 0u) { xcd_barrier_complete(bar, b.x, nloc, nx); b.st[0] = nloc; b.st[1] = nx; }
        const unsigned old = xb_add(&bar[XB_XSUB(b.x)], 1u);
        const unsigned gen = old / nloc;
        if (old + 1u == (gen + 1u) * nloc) {
            __builtin_amdgcn_fence(__ATOMIC_RELEASE, "agent");
            asm volatile("s_waitcnt vmcnt(0)" ::: "memory");
            const unsigned og = xb_add(&bar[XB_TOP], 1u);
            const unsigned tg = og / nx;
            if (og + 1u == (tg + 1u) * nx) xb_add(&bar[XB_TOPGEN], 1u);
            else XB_SPIN(xb_ld(&bar[XB_TOPGEN]) == tg, bar);
            __builtin_amdgcn_fence(__ATOMIC_ACQUIRE, "agent");
            xb_add(&bar[XB_XGEN(b.x)], 1u);
            asm volatile("s_waitcnt vmcnt(0)" ::: "memory");
        } else {
            XB_SPIN(xb_ld(&bar[XB_XGEN(b.x)]) == gen, bar);
            __builtin_amdgcn_fence(__ATOMIC_ACQUIRE, "agent");
            asm volatile("s_waitcnt vmcnt(0)" ::: "memory");
        }
    }
    __syncthreads();
}

struct Args { const float* in[22]; const int* page_table; float* out; unsigned char* ws; int ph_lo, ph_hi; };
struct Frame {
    LAS unsigned char* lds;
    int tid, lane, wave, vcu, G;
    const float *xp, *xs, *cache_k, *cache_v, *cache_ik, *state_pool, *cp, *cs, *w_ada, *b_ada, *g1, *w_in, *w_grp, *pool_scale, *w_up_pool, *w_up_attn, *w_out, *g2, *w_ffn_in, *w_ffn_out, *g_final;
    const int* page_table;
    float* out; unsigned char* ws;
};
__device__ __forceinline__ int bidx_of(int m) { return m < TP ? (m >> 12) : NB + ((m - TP) >> 2); }
__device__ __forceinline__ const float* xrow_of(const Frame& F, int m) { return m < TP ? F.xp + (size_t)m * D : F.xs + (size_t)(m - TP) * D; }

__device__ __forceinline__ int win_dst_row(int n) { return n < 5120 ? n : (n < 5184 ? 9216 + (n - 5120) : (n < 5200 ? 9280 + (n - 5184) : (n < 7248 ? 5120 + (n - 5200) : 7168 + (n - 7248)))); }
__device__ __forceinline__ int wfi_dst_row(int n) { const int j = n < DFF ? n : n - DFF; return (j >> 7) * 256 + (n < DFF ? 0 : 128) + (j & 127); }
struct TrItem { const float* W; bf16* WT; int K, N, ldt, coff, row_off, map, item; };
__device__ __forceinline__ void p0_load(const TrItem& t, float (&x)[32], int lane) {
    const int nblk = (t.N + 31) / 32, kb = t.item / nblk, nb = t.item % nblk, k0 = 64 * kb, n0 = 32 * nb;
    const int nl = n0 + (lane & 31); const bool ok = nl < t.N;
    const float* p = t.W + (size_t)(k0 + (lane >> 5)) * t.N + (ok ? nl : 0);
#pragma unroll
    for (int i = 0; i < 32; ++i) { const float v = __builtin_nontemporal_load(p + (size_t)(2 * i) * t.N); x[i] = ok ? v : 0.f; }
}
__device__ __forceinline__ void p0_store(const TrItem& t, const float (&x)[32], LAS float* scr, int lane) {
    const int nblk = (t.N + 31) / 32, kb = t.item / nblk, nb = t.item % nblk, k0 = 64 * kb, n0 = 32 * nb;
#pragma unroll
    for (int i = 0; i < 32; ++i) scr[(2 * i + (lane >> 5)) * 33 + (lane & 31)] = x[i];
    LDS_WAIT(); asm volatile("" ::: "memory");
    const int c = lane & 7;
#pragma unroll
    for (int j = 0; j < 4; ++j) { const int n = (lane >> 3) + 8 * j; const LAS float* sp = scr + (8 * c) * 33 + n;
        v4u o; o.x = cvt_pk_bf16(sp[0 * 33], sp[1 * 33]); o.y = cvt_pk_bf16(sp[2 * 33], sp[3 * 33]); o.z = cvt_pk_bf16(sp[4 * 33], sp[5 * 33]); o.w = cvt_pk_bf16(sp[6 * 33], sp[7 * 33]);
        const int ns = n0 + n;
        if (ns < t.N) { const int dr = t.map == 1 ? win_dst_row(ns) : (t.map == 2 ? wfi_dst_row(ns) : ns);
            *(v4u*)(t.WT + (size_t)(t.row_off + dr) * t.ldt + t.coff + k0 + 8 * c) = o; } }
    LDS_WAIT(); asm volatile("" ::: "memory");
}
__device__ __forceinline__ TrItem p0_decode(const Frame& F, int it) {
    bf16* W1T = (bf16*)(F.ws + WS_W1T); bf16* WUPT = (bf16*)(F.ws + WS_WUPT); bf16* WOUTT = (bf16*)(F.ws + WS_WOUTT); bf16* WFIT = (bf16*)(F.ws + WS_WFIT); bf16* WFOT = (bf16*)(F.ws + WS_WFOT); bf16* WGT = (bf16*)(F.ws + WS_WGT);
    constexpr int I_IN = (D / 64) * ((INW + 31) / 32), I_UP = (PW / 64) * (D / 32), I_UA = (AW / 64) * (D / 32), I_OUT = (D / 64) * (D / 32), I_FI = (D / 64) * (2 * DFF / 32), I_FO = (DFF / 64) * (D / 32), I_G1 = (PG / 64) * (PG / 32);
    int r = it;
    if (r < I_FI) return TrItem{F.w_ffn_in, WFIT, D, 2 * DFF, D, 0, 0, 2, r}; r -= I_FI;
    if (r < I_IN) return TrItem{F.w_in, W1T, D, INW, D, 0, 0, 1, r}; r -= I_IN;
    if (r < I_FO) return TrItem{F.w_ffn_out, WFOT, DFF, D, DFF, 0, 0, 0, r}; r -= I_FO;
    if (r < I_UA) return TrItem{F.w_up_attn, WUPT, AW, D, 3072, PW, 0, 0, r}; r -= I_UA;
    if (r < I_OUT) return TrItem{F.w_out, WOUTT, D, D, D, 0, 0, 0, r}; r -= I_OUT;
    if (r < I_UP) return TrItem{F.w_up_pool, WUPT, PW, D, 3072, 0, 0, 0, r}; r -= I_UP;
    const int g = r / I_G1; return TrItem{F.w_grp + (size_t)g * PG * PG, WGT, PG, PG, PG, 0, g * PG, 0, r % I_G1};
}
__device__ __forceinline__ void p0_prologue(Frame& F) {
    LAS float* scr = (LAS float*)(F.lds + F.wave * 16384);
    const int gw = F.vcu * NWAVES + F.wave, NGW = F.G * NWAVES;
    bf16* W1T = (bf16*)(F.ws + WS_W1T);
    constexpr int NITEMS = (D / 64) * ((INW + 31) / 32) + (PW / 64) * (D / 32) + (AW / 64) * (D / 32) + (D / 64) * (D / 32) + (D / 64) * (2 * DFF / 32) + (DFF / 64) * (D / 32) + 4 * (PG / 64) * (PG / 32);
    if (gw < NITEMS) {
        float xa[32], xb[32];
        TrItem ta = p0_decode(F, gw), tb = ta;
        p0_load(ta, xa, F.lane);
        for (int it = gw; it < NITEMS; it += 2 * NGW) {
            const bool hb = it + NGW < NITEMS, ha = it + 2 * NGW < NITEMS;
            if (hb) { tb = p0_decode(F, it + NGW); p0_load(tb, xb, F.lane); }
            p0_store(ta, xa, scr, F.lane);
            if (ha) { ta = p0_decode(F, it + 2 * NGW); p0_load(ta, xa, F.lane); }
            if (hb) p0_store(tb, xb, scr, F.lane);
        }
    }
    for (int i = gw * 64 + F.lane; i < 176 * 256; i += NGW * 64) *(v4u*)(W1T + (size_t)INW * D + (size_t)i * 8) = (v4u){0u, 0u, 0u, 0u};
    if (gw == 0) { unsigned* idn = (unsigned*)(F.ws + WS_IDENT); for (int i = F.lane; i < TOPK; i += 64) idn[i] = (unsigned)i; }
    for (int i = gw * 64 + F.lane; i < NCOND * NADA / 4; i += NGW * 64) *(f32x4*)((float*)(F.ws + WS_MODS) + (size_t)i * 4) = (f32x4){0.f, 0.f, 0.f, 0.f};
    bf16* SC = (bf16*)(F.ws + WS_SC);
    for (int i = gw * 64 + F.lane; i < 144 * D / 4; i += NGW * 64) { const int row = i / (D / 4), c4 = (i % (D / 4)) * 4;
        f32x4 v = (f32x4){0.f, 0.f, 0.f, 0.f};
        if (row < NB) v = *(const f32x4*)(F.cp + (size_t)row * D + c4); else if (row < NCOND) v = *(const f32x4*)(F.cs + (size_t)(row - NB) * D + c4);
        v2u o; o.x = cvt_pk_bf16(siluf_(v.x), siluf_(v.y)); o.y = cvt_pk_bf16(siluf_(v.z), siluf_(v.w)); *(v2u*)(SC + (size_t)row * D + c4) = o; }
    for (int i = gw * 64 + F.lane; i < NSEQ * 11 * (PW / 4); i += NGW * 64) { const int n = i / (11 * (PW / 4)), rem = i % (11 * (PW / 4)), j = rem / (PW / 4), c4 = (rem % (PW / 4)) * 4;
        *(f32x4*)(F.out + OUT_PS + ((size_t)n * PBUF + j) * PW + c4) = *(const f32x4*)(F.state_pool + ((size_t)n * PBUF + 4 + j) * PW + c4); }
}

constexpr int ADA_LD = 72;
__device__ __forceinline__ void p1_adaln(Frame& F) {
    const int lane = F.lane, r16 = lane & 15, g = lane >> 4, w = F.wave, tid = F.tid;
    const bf16* SC = (const bf16*)(F.ws + WS_SC); float* MODS = (float*)(F.ws + WS_MODS);
    LAS bf16* scb = (LAS bf16*)F.lds;
    for (int it = (int)blockIdx.x; it < 2 * (NADA / 128); it += F.G) {
        const int cb = it % (NADA / 128), kh = it / (NADA / 128), c0 = kh * (D / 128), cend = c0 + D / 128;
        const int n0 = cb * 128 + 16 * w;
        f32x4 acc[9];
#pragma unroll
        for (int rt = 0; rt < 9; ++rt) acc[rt] = (f32x4){0.f, 0.f, 0.f, 0.f};
        const float* wp = F.w_ada + (size_t)(8 * g) * NADA + n0 + r16;
        float xw[4][2][8]; v4u scr[2][3];
#pragma unroll
        for (int b = 0; b < 3; ++b)
#pragma unroll
            for (int ks = 0; ks < 2; ++ks)
#pragma unroll
                for (int j = 0; j < 8; ++j) xw[b][ks][j] = __builtin_nontemporal_load(wp + (size_t)(64 * (c0 + b) + 32 * ks + j) * NADA);
        __syncthreads();
#pragma unroll
        for (int p = 0; p < 3; ++p) { const int i = tid + 512 * p; if (i < 144 * 8) { *(LAS v4u*)(scb + (i >> 3) * ADA_LD + (i & 7) * 8) = *(const v4u*)(SC + (size_t)(i >> 3) * D + 64 * c0 + (i & 7) * 8);
            scr[1][p] = *(const v4u*)(SC + (size_t)(i >> 3) * D + 64 * (c0 + 1) + (i & 7) * 8); } }
        __syncthreads();
#pragma unroll 1
        for (int c = c0; c < cend; c += 4) {
#pragma unroll
            for (int h4 = 0; h4 < 4; ++h4) {
                const int cc = c + h4, cur = h4, n3 = (h4 + 3) & 3, lcur = h4 & 1, lnxt = lcur ^ 1; const bool more = cc + 1 < cend, more2 = cc + 2 < cend, more3 = cc + 3 < cend;
                if (more3) {
#pragma unroll
                    for (int ks = 0; ks < 2; ++ks)
#pragma unroll
                        for (int j = 0; j < 8; ++j) xw[n3][ks][j] = __builtin_nontemporal_load(wp + (size_t)(64 * (cc + 3) + 32 * ks + j) * NADA); }
                if (more2) {
#pragma unroll
                    for (int p = 0; p < 3; ++p) { const int i = tid + 512 * p; if (i < 144 * 8) scr[h4 & 1][p] = *(const v4u*)(SC + (size_t)(i >> 3) * D + 64 * (cc + 2) + (i & 7) * 8); } }
                const LAS bf16* sb = scb + lcur * 144 * ADA_LD + r16 * ADA_LD + 8 * g;
#pragma unroll
                for (int ks = 0; ks < 2; ++ks) { const float* x = xw[cur][ks];
                    v4u bw; bw.x = cvt_pk_bf16(x[0], x[1]); bw.y = cvt_pk_bf16(x[2], x[3]); bw.z = cvt_pk_bf16(x[4], x[5]); bw.w = cvt_pk_bf16(x[6], x[7]);
                    const bf16x8 bfrag = __builtin_bit_cast(bf16x8, bw);
#pragma unroll
                    for (int rt = 0; rt < 9; ++rt) { const bf16x8 af = *(const LAS bf16x8*)(sb + rt * 16 * ADA_LD + 32 * ks); acc[rt] = __builtin_amdgcn_mfma_f32_16x16x32_bf16(af, bfrag, acc[rt], 0, 0, 0); } }
                if (more) {
#pragma unroll
                    for (int p = 0; p < 3; ++p) { const int i = tid + 512 * p; if (i < 144 * 8) *(LAS v4u*)(scb + lnxt * 144 * ADA_LD + (i >> 3) * ADA_LD + (i & 7) * 8) = scr[(h4 + 1) & 1][p]; } }
                __syncthreads();
            }
        }
        int le = fresh_lane(); asm volatile("" : "+v"(le));
        const int r16e = le & 15, ge = le >> 4;
        const float bias = kh == 0 ? F.b_ada[n0 + r16e] : 0.f;
#pragma unroll
        for (int rt = 0; rt < 9; ++rt)
#pragma unroll
            for (int i = 0; i < 4; ++i) { const int row = 16 * rt + 4 * ge + i; if (row < NCOND) (void)__hip_atomic_fetch_add(MODS + (size_t)row * NADA + n0 + r16e, acc[rt][i] + bias, __ATOMIC_RELAXED, __HIP_MEMORY_SCOPE_AGENT); }
    }
    __syncthreads();
}

__device__ __forceinline__ f32x4 ld_bf16x4(const bf16* p) { const v2u w = *(const v2u*)p;
    return (f32x4){__builtin_bit_cast(float, w.x << 16), __builtin_bit_cast(float, w.x & 0xffff0000u), __builtin_bit_cast(float, w.y << 16), __builtin_bit_cast(float, w.y & 0xffff0000u)}; }
__device__ __forceinline__ void st_bf16x4(bf16* p, const f32x4 a) { v2u w; w.x = cvt_pk_bf16(a[0], a[1]); w.y = cvt_pk_bf16(a[2], a[3]); *(v2u*)p = w; }
__device__ __forceinline__ float wave_sum(float v) {
#pragma unroll
    for (int o = 1; o < 64; o <<= 1) v += __shfl_xor(v, o);
    return v;
}
template <int NSLAB>
__device__ __forceinline__ void modulate_row(const float* xrow, const float* g, const float* shift, const float* scale, bf16* orow, int lane, const float* slab, const float* gate, float* hrow) {
    f32x4 v[8]; float ss = 0.f;
#pragma unroll
    for (int j = 0; j < 8; ++j) { const int c = 4 * lane + 256 * j; v[j] = *(const f32x4*)(xrow + c);
        if (NSLAB > 0) { f32x4 a = (f32x4){0.f, 0.f, 0.f, 0.f};
#pragma unroll
            for (int sidx = 0; sidx < NSLAB; ++sidx) a += *(const f32x4*)(slab + (size_t)sidx * TS * D + c);
            v[j] += *(const f32x4*)(gate + c) * a; *(f32x4*)(hrow + c) = v[j]; }
        ss += (v[j].x * v[j].x + v[j].y * v[j].y) + (v[j].z * v[j].z + v[j].w * v[j].w); }
    const float rstd = 1.0f / sqrtf(wave_sum(ss) * (1.0f / D) + EPS);
#pragma unroll
    for (int j = 0; j < 8; ++j) { const int c = 4 * lane + 256 * j;
        const f32x4 gg = *(const f32x4*)(g + c), sh = *(const f32x4*)(shift + c), sc = *(const f32x4*)(scale + c);
        const f32x4 o = (v[j] * rstd * gg) * (sc + 1.0f) + sh;
        v2u w; w.x = cvt_pk_bf16(o.x, o.y); w.y = cvt_pk_bf16(o.z, o.w); *(v2u*)(orow + c) = w; }
}
template <int NSLAB>
__device__ __forceinline__ void final_norm_row(const float* xrow, const float* g, float* orow, int lane, const float* slab, const float* gate) {
    f32x4 v[8]; float ss = 0.f;
#pragma unroll
    for (int j = 0; j < 8; ++j) { const int c = 4 * lane + 256 * j; v[j] = *(const f32x4*)(xrow + c);
        if (NSLAB > 0) { f32x4 a = (f32x4){0.f, 0.f, 0.f, 0.f};
#pragma unroll
            for (int sidx = 0; sidx < NSLAB; ++sidx) a += *(const f32x4*)(slab + (size_t)sidx * TS * D + c);
            v[j] += *(const f32x4*)(gate + c) * a; }
        ss += (v[j].x * v[j].x + v[j].y * v[j].y) + (v[j].z * v[j].z + v[j].w * v[j].w); }
    const float rstd = 1.0f / sqrtf(wave_sum(ss) * (1.0f / D) + EPS);
#pragma unroll
    for (int j = 0; j < 8; ++j) { const int c = 4 * lane + 256 * j; const f32x4 gg = *(const f32x4*)(g + c); *(f32x4*)(orow + c) = v[j] * rstd * gg; }
}


__device__ __forceinline__ void row_load(f32x4 (&v)[8], const float* xrow, int lane) {
#pragma unroll
    for (int j = 0; j < 8; ++j) v[j] = __builtin_nontemporal_load((const f32x4*)(xrow + 4 * lane + 256 * j));
}
__device__ __forceinline__ float row_rstd(const f32x4 (&v)[8]) {
    float ss = 0.f;
#pragma unroll
    for (int j = 0; j < 8; ++j) ss += (v[j].x * v[j].x + v[j].y * v[j].y) + (v[j].z * v[j].z + v[j].w * v[j].w);
    return 1.0f / sqrtf(wave_sum(ss) * (1.0f / D) + EPS);
}
__device__ __forceinline__ void row_store_mod(const f32x4 (&v)[8], float rstd, const float* g, const float* shift, const float* scale, bf16* orow, int lane) {
#pragma unroll
    for (int j = 0; j < 8; ++j) { const int c = 4 * lane + 256 * j;
        const f32x4 gg = *(const f32x4*)(g + c), sh = *(const f32x4*)(shift + c), sc = *(const f32x4*)(scale + c);
        const f32x4 o = (v[j] * rstd * gg) * (sc + 1.0f) + sh;
        v2u w; w.x = cvt_pk_bf16(o.x, o.y); w.y = cvt_pk_bf16(o.z, o.w); *(v2u*)(orow + c) = w; }
}
__device__ __forceinline__ void row_store_final(const f32x4 (&v)[8], float rstd, const float* g, float* orow, int lane) {
#pragma unroll
    for (int j = 0; j < 8; ++j) { const int c = 4 * lane + 256 * j; const f32x4 gg = *(const f32x4*)(g + c); *(f32x4*)(orow + c) = v[j] * rstd * gg; }
}
__device__ __forceinline__ void mod_vec_load(f32x4 (&A)[8], f32x4 (&B)[8], const float* g, const float* shift, const float* scale, int lane) {
#pragma unroll
    for (int j = 0; j < 8; ++j) { const int c = 4 * lane + 256 * j; A[j] = *(const f32x4*)(g + c) * (*(const f32x4*)(scale + c) + 1.0f); B[j] = *(const f32x4*)(shift + c); }
}
__device__ __forceinline__ void row_store_ab(const f32x4 (&v)[8], float rstd, const f32x4 (&A)[8], const f32x4 (&B)[8], bf16* orow, int lane) {
#pragma unroll
    for (int j = 0; j < 8; ++j) { const int c = 4 * lane + 256 * j; const f32x4 o = (v[j] * rstd) * A[j] + B[j];
        v2u w; w.x = cvt_pk_bf16(o.x, o.y); w.y = cvt_pk_bf16(o.z, o.w); *(v2u*)(orow + c) = w; }
}
__device__ __forceinline__ void row_load16(f32x4 (&v)[8], const bf16* xrow, int lane) {
#pragma unroll
    for (int j = 0; j < 8; ++j) { const v2u w = __builtin_nontemporal_load((const v2u*)(xrow + 4 * lane + 256 * j));
        v[j] = (f32x4){__builtin_bit_cast(float, w.x << 16), __builtin_bit_cast(float, w.x & 0xffff0000u), __builtin_bit_cast(float, w.y << 16), __builtin_bit_cast(float, w.y & 0xffff0000u)}; }
}
template <bool SRC16>
__device__ __forceinline__ void mod_rows(const Frame& F, const void* src_, int r0, int r1, int row_base, const float* g, int moff, bf16* U, int lane) {
    const float* MODS = (const float*)(F.ws + WS_MODS); const float* src = (const float*)src_; const bf16* src16 = (const bf16*)src_;
    if (r0 >= r1) return;
    f32x4 b0[8], b1[8], b2[8], A[8], B[8]; int cb = -1;
#define MR_LOAD(BUF, rr) do { if (SRC16) row_load16(BUF, src16 + (size_t)(rr) * D, lane); else row_load(BUF, src + (size_t)(rr) * D, lane); } while (0)
#define MR_STEP(C, L, rr) do { if ((rr) < r1) { if ((rr) + 2 < r1) MR_LOAD(L, (rr) + 2); \
        const int b = bidx_of(row_base + (rr)); if (b != cb) { const float* md = MODS + (size_t)b * NADA + moff; mod_vec_load(A, B, g, md, md + D, lane); cb = b; } \
        row_store_ab(C, row_rstd(C), A, B, U + (size_t)(row_base + (rr)) * D, lane); } } while (0)
    MR_LOAD(b0, r0); if (r0 + 1 < r1) MR_LOAD(b1, r0 + 1);
    for (int r = r0; r < r1; r += 3) { MR_STEP(b0, b2, r); MR_STEP(b1, b0, r + 1); MR_STEP(b2, b1, r + 2); }
#undef MR_LOAD
#undef MR_STEP
}
template <int NSLAB, bool X16>
__device__ __forceinline__ f32x4 coop_row(const Frame& F, const void* xrow_, const float* slab, const float* gate, LAS float* red, float& rstd) {
    const int c = 256 * F.wave + 4 * F.lane;
    f32x4 a = (f32x4){0.f, 0.f, 0.f, 0.f};
#pragma unroll
    for (int sidx = 0; sidx < NSLAB; ++sidx) a += *(const f32x4*)(slab + (size_t)sidx * TS * D + c);
    const f32x4 v = (X16 ? ld_bf16x4((const bf16*)xrow_ + c) : *(const f32x4*)((const float*)xrow_ + c)) + *(const f32x4*)(gate + c) * a;
    const float ss = wave_sum((v.x * v.x + v.y * v.y) + (v.z * v.z + v.w * v.w));
    if (F.lane == 0) red[F.wave] = ss;
    __syncthreads();
    float t = 0.f;
#pragma unroll
    for (int w = 0; w < NWAVES; ++w) t += red[w];
    rstd = 1.0f / sqrtf(t * (1.0f / D) + EPS);
    return v;
}

__device__ __forceinline__ void st_bf16x8(bf16* p, const f32x4 a, const f32x4 b) { v4u w; w.x = cvt_pk_bf16(a[0], a[1]); w.y = cvt_pk_bf16(a[2], a[3]); w.z = cvt_pk_bf16(b[0], b[1]); w.w = cvt_pk_bf16(b[2], b[3]); *(v4u*)p = w; }
__device__ __forceinline__ v2u pk_fp8x8(const f32x4 a, const f32x4 b) { v2u w; int t = __builtin_amdgcn_cvt_pk_fp8_f32(a[0], a[1], 0, false); w.x = (unsigned)__builtin_amdgcn_cvt_pk_fp8_f32(a[2], a[3], t, true);
    t = __builtin_amdgcn_cvt_pk_fp8_f32(b[0], b[1], 0, false); w.y = (unsigned)__builtin_amdgcn_cvt_pk_fp8_f32(b[2], b[3], t, true); return w; }
__device__ __forceinline__ f32x4 sig4(const f32x4 a) { return (f32x4){sigmoidf_(a[0]), sigmoidf_(a[1]), sigmoidf_(a[2]), sigmoidf_(a[3])}; }
__device__ __forceinline__ void ld_bf16x8(const bf16* p, f32x4& a, f32x4& b) { const v4u w = *(const v4u*)p;
    a = (f32x4){__builtin_bit_cast(float, w.x << 16), __builtin_bit_cast(float, w.x & 0xffff0000u), __builtin_bit_cast(float, w.y << 16), __builtin_bit_cast(float, w.y & 0xffff0000u)};
    b = (f32x4){__builtin_bit_cast(float, w.z << 16), __builtin_bit_cast(float, w.z & 0xffff0000u), __builtin_bit_cast(float, w.w << 16), __builtin_bit_cast(float, w.w & 0xffff0000u)}; }

struct EpiIn {
    static constexpr bool PERM = true, HAS_MID = false; int mid_t;
    float* out; float* pin; bf16 *q, *kb, *vb, *qi, *ga, *gb, *ki; float* wi; unsigned char *k8, *v8;
    __device__ __forceinline__ void mid(pg8::f32x4 (&)[2][2][4][2], const pg8::Unit&, int, int, int, int) const {}
#define EPI_LOOP(BODY) _Pragma("unroll") for (int ai = 0; ai < 2; ++ai) _Pragma("unroll") for (int m = 0; m < 4; ++m) { const int r = row0 + ai * 128 + m * 16; _Pragma("unroll") for (int bj = 0; bj < 2; ++bj) { \
        const int cl = cl0 + bj * 128; const f32x4 v0 = acc[ai][bj][m][0], v1 = acc[ai][bj][m][1]; BODY } }
    __device__ __forceinline__ void operator()(const pg8::f32x4 (&acc)[2][2][4][2], const pg8::Unit& u, int wr, int wc, int fr, int fq) const {
        const int pn = u.pn, row0 = u.pm * 256 + wr * 64 + fr, cl0 = wc * 32 + 8 * fq;
        if (pn < 4) {
            EPI_LOOP({ const int c = pn * 256 + cl; float* p = pin + (size_t)r * PW + c; *(f32x4*)p = v0; *(f32x4*)(p + 4) = v1;
                if (r < TP) { const int t = r & (SEQ - 1); if (t >= SEQ - PBUF) { float* o = out + OUT_PP + ((size_t)(r >> 12) * PBUF + (t - (SEQ - PBUF))) * PW + c; *(f32x4*)o = v0; *(f32x4*)(o + 4) = v1; } }
                else { const int rr = r - TP; float* o = out + OUT_PS + ((size_t)(rr >> 2) * PBUF + 11 + (rr & 3)) * PW + c; *(f32x4*)o = v0; *(f32x4*)(o + 4) = v1; } })
        } else if (pn >= 12 && pn < 16) { const bool isv = pn >= 14; const int cb = ((pn - 12) & 1) * 256; bf16* hb = isv ? vb : kb; unsigned char* h8 = isv ? v8 : k8;
            float* op = out + (isv ? OUT_VP : OUT_KP); float* os = out + (isv ? OUT_VS : OUT_KS);
            EPI_LOOP({ const int c = cb + cl; st_bf16x8(hb + (size_t)r * KVW + c, v0, v1);
                float* o = r < TP ? op + (size_t)r * KVW + c : os + (size_t)(r - TP) * KVW + c; *(f32x4*)o = v0; *(f32x4*)(o + 4) = v1;
                if (r < TP) { const int d0 = c & 127; *(v2u*)(h8 + (size_t)r * KVW + (isv ? c : (c & ~127) + ((d0 >> 3) & 3) * 32 + (d0 >> 5) * 8)) = pk_fp8x8(v0, v1); } })
        } else if (pn >= 36) {
            EPI_LOOP({ if (cl < IDD) { st_bf16x8(ki + (size_t)r * IDD + cl, v0, v1);
                           float* o = r < TP ? out + OUT_IKP + (size_t)r * IDD + cl : out + OUT_IKS + (size_t)(r - TP) * IDD + cl; *(f32x4*)o = v0; *(f32x4*)(o + 4) = v1; }
                       else if (cl < IDD + NIH) { float* o = wi + (size_t)r * NIH + (cl - IDD); *(f32x4*)o = v0; *(f32x4*)(o + 4) = v1; } })
        } else if (pn < 12) { bf16* qb = q + (pn - 4) * 256;
            EPI_LOOP({ st_bf16x8(qb + (size_t)r * AW + cl, v0, v1); })
        } else if (pn < 20) { bf16* qb = qi + (pn - 16) * 256;
            EPI_LOOP({ st_bf16x8(qb + (size_t)r * QIW + cl, v0, v1); })
        } else if (pn < 36) { bf16* gp = (pn < 28 ? ga + (pn - 20) * 256 : gb + (pn - 28) * 256);
            EPI_LOOP({ st_bf16x8(gp + (size_t)r * D + cl, sig4(v0), sig4(v1)); })
        }
    }
#undef EPI_LOOP
};
struct EpiPool {
    static constexpr bool PERM = true, HAS_MID = false; int mid_t;
    bf16* pa; const float* scale;
    __device__ __forceinline__ void mid(pg8::f32x4 (&)[2][2][4][2], const pg8::Unit&, int, int, int, int) const {}
    __device__ __forceinline__ void operator()(const pg8::f32x4 (&acc)[2][2][4][2], const pg8::Unit& u, int wr, int wc, int fr, int fq) const {
        const int row0 = u.pm * 256 + wr * 64 + fr, c0 = u.pn * 256 + wc * 32 + 8 * fq;
        f32x4 s[2][2];
#pragma unroll
        for (int bj = 0; bj < 2; ++bj) { s[bj][0] = *(const f32x4*)(scale + c0 + bj * 128); s[bj][1] = *(const f32x4*)(scale + c0 + bj * 128 + 4); }
#pragma unroll
        for (int ai = 0; ai < 2; ++ai)
#pragma unroll
            for (int m = 0; m < 4; ++m) { const int r = row0 + ai * 128 + m * 16;
#pragma unroll
                for (int bj = 0; bj < 2; ++bj) st_bf16x8(pa + (size_t)r * 3072 + c0 + bj * 128, acc[ai][bj][m][0] * s[bj][0], acc[ai][bj][m][1] * s[bj][1]); }
    }
};
template <bool SECOND> struct EpiMix {
    static constexpr bool PERM = true, HAS_MID = false; int mid_t;
    const bf16* gate; float* t1; bf16* mix;
    __device__ __forceinline__ void mid(pg8::f32x4 (&)[2][2][4][2], const pg8::Unit&, int, int, int, int) const {}
    __device__ __forceinline__ void operator()(const pg8::f32x4 (&acc)[2][2][4][2], const pg8::Unit& u, int wr, int wc, int fr, int fq) const {
        const int row0 = u.pm * 256 + wr * 64 + fr, c0 = u.pn * 256 + wc * 32 + 8 * fq;
#pragma unroll
        for (int ai = 0; ai < 2; ++ai)
#pragma unroll
            for (int m = 0; m < 4; ++m) { const size_t ro = (size_t)(row0 + ai * 128 + m * 16) * D + c0;
#pragma unroll
                for (int bj = 0; bj < 2; ++bj) { f32x4 b0, b1; ld_bf16x8(gate + ro + bj * 128, b0, b1); float* tp = t1 + ro + bj * 128;
                    (void)tp;
                    if (!SECOND) st_bf16x8(mix + ro + bj * 128, acc[ai][bj][m][0] * b0, acc[ai][bj][m][1] * b1);
                    else { f32x4 x0, x1; ld_bf16x8(mix + ro + bj * 128, x0, x1); st_bf16x8(mix + ro + bj * 128, x0 + acc[ai][bj][m][0] * b0, x1 + acc[ai][bj][m][1] * b1); } }
                if (m & 1) asm volatile("" ::: "memory"); }
    }
};
struct EpiMixFused {
    static constexpr bool PERM = true, HAS_MID = true; static constexpr int MID_T = PW / 64; int mid_t;
    const bf16 *ga, *gb; bf16* mix;
    __device__ __forceinline__ void mid(pg8::f32x4 (&acc)[2][2][4][2], const pg8::Unit& u, int wr, int wc, int fr, int fq) const {
        int row0 = u.pm * 256 + wr * 64 + fr, c0 = u.pn * 256 + wc * 32 + 8 * fq;
        asm volatile("" : "+v"(row0), "+v"(c0));
#pragma unroll
        for (int ai = 0; ai < 2; ++ai)
#pragma unroll
            for (int m = 0; m < 4; ++m) { const size_t ro = (size_t)(row0 + ai * 128 + m * 16) * D + c0;
#pragma unroll
                for (int bj = 0; bj < 2; ++bj) { f32x4 a0, a1, b0, b1; ld_bf16x8(ga + ro + bj * 128, a0, a1); ld_bf16x8(gb + ro + bj * 128, b0, b1);
#pragma unroll
                    for (int i = 0; i < 4; ++i) { acc[ai][bj][m][0][i] *= a0[i] * __builtin_amdgcn_rcpf(b0[i]); acc[ai][bj][m][1][i] *= a1[i] * __builtin_amdgcn_rcpf(b1[i]); } }
                asm volatile("" ::: "memory"); }
    }
    __device__ __forceinline__ void operator()(const pg8::f32x4 (&acc)[2][2][4][2], const pg8::Unit& u, int wr, int wc, int fr, int fq) const {
        const int row0 = u.pm * 256 + wr * 64 + fr, c0 = u.pn * 256 + wc * 32 + 8 * fq;
#pragma unroll
        for (int ai = 0; ai < 2; ++ai)
#pragma unroll
            for (int m = 0; m < 4; ++m) { const size_t ro = (size_t)(row0 + ai * 128 + m * 16) * D + c0;
#pragma unroll
                for (int bj = 0; bj < 2; ++bj) { f32x4 b0, b1; ld_bf16x8(gb + ro + bj * 128, b0, b1); st_bf16x8(mix + ro + bj * 128, acc[ai][bj][m][0] * b0, acc[ai][bj][m][1] * b1); }
                if (m & 1) asm volatile("" ::: "memory"); }
    }
};
template <bool BASE16, bool OUT16> struct EpiRes {
    static constexpr bool PERM = false, HAS_MID = false; int mid_t;
    const float *base_p, *base_s; float* o; const float* mods; int moff; const bf16* base16; bf16* o16;
    __device__ __forceinline__ void mid(pg8::f32x4 (&)[2][2][4][2], const pg8::Unit&, int, int, int, int) const {}
    __device__ __forceinline__ void operator()(const pg8::f32x4 (&acc)[2][2][4][2], const pg8::Unit& u, int wr, int wc, int fr, int fq) const {
        const int row0 = u.pm * 256 + wr * 64 + fr, c0 = u.pn * 256 + wc * 32 + 4 * fq;
#pragma unroll
        for (int ai = 0; ai < 2; ++ai)
#pragma unroll
            for (int m = 0; m < 4; ++m) { const int r = row0 + ai * 128 + m * 16;
                const float* bp = (r < TP ? base_p + (size_t)r * D : base_s + (size_t)(r - TP) * D) + c0; const float* mp = mods + (size_t)bidx_of(r) * NADA + moff + c0; float* op = o + (size_t)r * D + c0;
                const bf16* bp16 = base16 + (size_t)r * D + c0; bf16* op16 = o16 + (size_t)r * D + c0;
#pragma unroll
                for (int bj = 0; bj < 2; ++bj)
#pragma unroll
                    for (int n = 0; n < 2; ++n) { const int co = bj * 128 + n * 16;
                        const f32x4 b = BASE16 ? ld_bf16x4(bp16 + co) : *(const f32x4*)(bp + co); const f32x4 v = b + *(const f32x4*)(mp + co) * acc[ai][bj][m][n];
                        if (OUT16) st_bf16x4(op16 + co, v); else *(f32x4*)(op + co) = v; }
                if (m & 1) asm volatile("" ::: "memory"); }
    }
};
template <bool GATED> struct EpiSlab {
    static constexpr bool PERM = false, HAS_MID = false; int mid_t;
    float* slab; const bf16 *ga, *gb; int gsplit;
    __device__ __forceinline__ void mid(pg8::f32x4 (&)[2][2][4][2], const pg8::Unit&, int, int, int, int) const {}
    __device__ __forceinline__ void operator()(const pg8::f32x4 (&acc)[2][2][4][2], const pg8::Unit& u, int wr, int wc, int fr, int fq) const {
        const int row0 = u.pm * 256 + wr * 64 + fr, c0 = u.pn * 256 + wc * 32 + 4 * fq;
        const bf16* gt = u.ks < gsplit ? ga : gb;
#pragma unroll
        for (int ai = 0; ai < 2; ++ai)
#pragma unroll
            for (int m = 0; m < 4; ++m) { const int r = row0 + ai * 128 + m * 16; float* op = slab + ((size_t)u.ks * TS + (r - TP)) * D + c0;
#pragma unroll
                for (int bj = 0; bj < 2; ++bj)
#pragma unroll
                    for (int n = 0; n < 2; ++n) { const int co = bj * 128 + n * 16; f32x4 v = acc[ai][bj][m][n];
                        if (GATED) { const v2u w = *(const v2u*)(gt + (size_t)r * D + c0 + co);
                            v *= (f32x4){__builtin_bit_cast(float, w.x << 16), __builtin_bit_cast(float, w.x & 0xffff0000u), __builtin_bit_cast(float, w.y << 16), __builtin_bit_cast(float, w.y & 0xffff0000u)}; }
                        *(f32x4*)(op + co) = v; }
                if (m & 1) asm volatile("" ::: "memory"); }
    }
};
struct EpiFfn {
    static constexpr bool PERM = true, HAS_MID = false; int mid_t;
    bf16* act;
    __device__ __forceinline__ void mid(pg8::f32x4 (&)[2][2][4][2], const pg8::Unit&, int, int, int, int) const {}
    __device__ __forceinline__ void operator()(const pg8::f32x4 (&acc)[2][2][4][2], const pg8::Unit& u, int wr, int wc, int fr, int fq) const {
        const int row0 = u.pm * 256 + wr * 64 + fr, c0 = u.pn * 128 + wc * 32 + 8 * fq;
#pragma unroll
        for (int ai = 0; ai < 2; ++ai)
#pragma unroll
            for (int m = 0; m < 4; ++m) { const int r = row0 + ai * 128 + m * 16; f32x4 o0, o1;
#pragma unroll
                for (int i = 0; i < 4; ++i) { o0[i] = siluf_(acc[ai][0][m][0][i]) * acc[ai][1][m][0][i]; o1[i] = siluf_(acc[ai][0][m][1][i]) * acc[ai][1][m][1][i]; }
                st_bf16x8(act + (size_t)r * DFF + c0, o0, o1); }
    }
};

constexpr int SG_LD = 65, SG_WAVE = 64 * SG_LD;
template <class EpiS>
__device__ __forceinline__ void sample_gemm(Frame& F, const bf16* A, int lda, const bf16* Bt, int ldb, int s0, int ns, const EpiS& E) {
    const int lane = F.lane, r16 = lane & 15, g = lane >> 4;
    LAS float* P = (LAS float*)F.lds;
    for (int tile = F.vcu; tile < (TS / 64) * (D / 64); tile += F.G) {
        const int rb = tile & 7, cb = tile >> 3;
        const bf16* ap = A + (size_t)(64 * rb + r16) * lda + 64 * s0 + 16 * g;
        const bf16* bp = Bt + (size_t)(64 * cb + r16) * ldb + 64 * s0 + 16 * g;
        f32x4 acc[4][4];
#pragma unroll
        for (int rt = 0; rt < 4; ++rt)
#pragma unroll
            for (int ct = 0; ct < 4; ++ct) acc[rt][ct] = (f32x4){0.f, 0.f, 0.f, 0.f};
        bf16x8 a[4][2], b[4][2], an[4][2], bn[4][2];
#pragma unroll
        for (int t = 0; t < 4; ++t)
#pragma unroll
            for (int h = 0; h < 2; ++h) { a[t][h] = *(const bf16x8*)(ap + (size_t)(16 * t) * lda + 8 * h); b[t][h] = *(const bf16x8*)(bp + (size_t)(16 * t) * ldb + 8 * h); }
#pragma unroll 1
        for (int st = 0; st < ns; ++st) {
            const bool more = st + 1 < ns;
            if (more) {
#pragma unroll
                for (int t = 0; t < 4; ++t)
#pragma unroll
                    for (int h = 0; h < 2; ++h) { an[t][h] = *(const bf16x8*)(ap + (size_t)(16 * t) * lda + 64 * (st + 1) + 8 * h); bn[t][h] = *(const bf16x8*)(bp + (size_t)(16 * t) * ldb + 64 * (st + 1) + 8 * h); } }
#pragma unroll
            for (int h = 0; h < 2; ++h)
#pragma unroll
                for (int rt = 0; rt < 4; ++rt)
#pragma unroll
                    for (int ct = 0; ct < 4; ++ct) acc[rt][ct] = __builtin_amdgcn_mfma_f32_16x16x32_bf16(a[rt][h], b[ct][h], acc[rt][ct], 0, 0, 0);
            if (more) {
#pragma unroll
                for (int t = 0; t < 4; ++t)
#pragma unroll
                    for (int h = 0; h < 2; ++h) { a[t][h] = an[t][h]; b[t][h] = bn[t][h]; } }
        }
        __syncthreads();
#pragma unroll
        for (int rt = 0; rt < 4; ++rt)
#pragma unroll
            for (int ct = 0; ct < 4; ++ct)
#pragma unroll
                for (int i = 0; i < 4; ++i) P[F.wave * SG_WAVE + (16 * rt + 4 * g + i) * SG_LD + 16 * ct + r16] = acc[rt][ct][i];
        __syncthreads();
        E(P, 64 * rb + (F.tid >> 3), 64 * cb + 8 * (F.tid & 7), (F.tid >> 3) * SG_LD + 8 * (F.tid & 7));
    }
    __syncthreads();
}
__device__ __forceinline__ void sg_sum(const LAS float* P, int o, int w0, int w1, f32x4& v0, f32x4& v1) {
    v0 = (f32x4){0.f, 0.f, 0.f, 0.f}; v1 = v0;
    for (int w = w0; w < w1; ++w) { const LAS float* p = P + w * SG_WAVE + o;
        v0 += (f32x4){p[0], p[1], p[2], p[3]}; v1 += (f32x4){p[4], p[5], p[6], p[7]}; }
}
struct SgMix { const bf16 *ga, *gb; bf16* mix;
    __device__ __forceinline__ void operator()(const LAS float* P, int r, int c, int o) const {
        f32x4 p0, p1, q0, q1; sg_sum(P, o, 0, 2, p0, p1); sg_sum(P, o, 2, NWAVES, q0, q1);
        const size_t ro = (size_t)(TP + r) * D + c; f32x4 a0, a1, b0, b1; ld_bf16x8(ga + ro, a0, a1); ld_bf16x8(gb + ro, b0, b1);
        st_bf16x8(mix + ro, p0 * a0 + q0 * b0, p1 * a1 + q1 * b1); } };
struct SgRes { const float* base; bf16* h16; const float* mods; int moff;
    __device__ __forceinline__ void operator()(const LAS float* P, int r, int c, int o) const {
        f32x4 v0, v1; sg_sum(P, o, 0, NWAVES, v0, v1);
        const float* bp = base + (size_t)r * D + c; const float* mp = mods + (size_t)bidx_of(TP + r) * NADA + moff + c;
        st_bf16x8(h16 + (size_t)(TP + r) * D + c, *(const f32x4*)bp + *(const f32x4*)mp * v0, *(const f32x4*)(bp + 4) + *(const f32x4*)(mp + 4) * v1); } };

template <int G>
__device__ __forceinline__ void pool_d_block(const float* PIN, bf16* DG, int b, int t0, int lane) {
    constexpr int W = 2 << G, HL = W - 1, c = G * PG;
    f32x4 x[16 + HL];
#pragma unroll
    for (int j = 0; j < 16 + HL; ++j) { const int t = t0 - HL + j; x[j] = t >= 0 ? *(const f32x4*)(PIN + (size_t)(b * SEQ + t) * PW + c + 4 * lane) : (f32x4){0.f, 0.f, 0.f, 0.f}; }
    f32x4 sw = x[0];
#pragma unroll
    for (int j = 1; j <= HL; ++j) sw += x[j];
#pragma unroll
    for (int i = 0; i < 16; ++i) { const int t = t0 + i; if (i > 0) sw += x[HL + i] - x[i - 1];
        const float cnt = (float)(t + 1 < W ? t + 1 : W); const f32x4 d = sw * (1.0f / cnt) - x[HL + i];
        v2u o; o.x = cvt_pk_bf16(d.x, d.y); o.y = cvt_pk_bf16(d.z, d.w); *(v2u*)(DG + ((size_t)G * MR + b * SEQ + t) * PG + 4 * lane) = o; }
}
__device__ __forceinline__ void p3_pool_d(Frame& F) {
    const int gw = F.vcu * NWAVES + F.wave, NGW = F.G * NWAVES, lane = F.lane;
    const float* PIN = (const float*)(F.ws + WS_PIN); bf16* DG = (bf16*)(F.ws + WS_DG);
    for (int job = gw; job < 4 * (TP / 16); job += NGW) { const int g = job / (TP / 16), blk = job % (TP / 16), b = blk / (SEQ / 16), t0 = (blk % (SEQ / 16)) * 16;
        if (g == 0) pool_d_block<0>(PIN, DG, b, t0, lane); else if (g == 1) pool_d_block<1>(PIN, DG, b, t0, lane); else if (g == 2) pool_d_block<2>(PIN, DG, b, t0, lane); else pool_d_block<3>(PIN, DG, b, t0, lane); }
    for (int m = TP + gw; m < MR; m += NGW) {
#pragma unroll
        for (int g = 0; g < 4; ++g) { const int w = 2 << g, c = g * PG + 4 * lane;
            const int rr = m - TP, n = rr >> 2, tt = rr & 3; const f32x4 cur = *(const f32x4*)(PIN + (size_t)m * PW + c); f32x4 sm = cur;
#pragma unroll
            for (int j = 1; j < w; ++j) { const int q = PBUF + tt - j;
                sm += q >= PBUF ? *(const f32x4*)(PIN + (size_t)(TP + 4 * n + q - PBUF) * PW + c) : *(const f32x4*)(F.state_pool + ((size_t)n * PBUF + q) * PW + c); }
            const f32x4 d = sm * (1.0f / (float)w) - cur;
            v2u o; o.x = cvt_pk_bf16(d.x, d.y); o.y = cvt_pk_bf16(d.z, d.w); *(v2u*)(DG + ((size_t)g * MR + m) * PG + 4 * lane) = o; }
    }
}

constexpr int QS_LD = QIW + 8;
__device__ __forceinline__ void idx_item(Frame& F, int qrow0  , int kt_lo, int kt_hi) {
    const int lane = F.lane, q = lane & 31, h = lane >> 5;
    const bf16* QI = (const bf16*)(F.ws + WS_QI); const bf16* KI = (const bf16*)(F.ws + WS_KI); const float* WI = (const float*)(F.ws + WS_WI);
    LAS bf16* Qs = (LAS bf16*)F.lds;
    __syncthreads();
    const bf16* kbase = KI + (size_t)((qrow0 & ~(SEQ - 1)) + q) * IDD + 8 * h;
    bf16x8 an[4];
    { const int kt0 = kt_lo + F.wave; if (kt0 < kt_hi) {
#pragma unroll
        for (int ks = 0; ks < 4; ++ks) an[ks] = *(const bf16x8*)(kbase + (size_t)kt0 * 32 * IDD + 16 * ks); } }
#pragma unroll
    for (int i = 0; i < 8; ++i) { const int ch = F.tid + 512 * i, r = ch >> 7, c8 = (ch & 127) * 8;
        *(LAS v4u*)(Qs + r * QS_LD + c8) = *(const v4u*)(QI + (size_t)(qrow0 + r) * QIW + c8); }
    LAS float* Ws = (LAS float*)(F.lds + 32 * QS_LD * 2);
    { const int hq = F.tid & 31, hh = F.tid >> 5; Ws[F.tid] = WI[(size_t)(qrow0 + hq) * NIH + hh] * 0.03125f; }
    __syncthreads();
    for (int kt = kt_lo + F.wave; kt < kt_hi; kt += NWAVES) {
        bf16x8 a[4];
#pragma unroll
        for (int ks = 0; ks < 4; ++ks) a[ks] = an[ks];
        if (kt + NWAVES < kt_hi) {
#pragma unroll
            for (int ks = 0; ks < 4; ++ks) an[ks] = *(const bf16x8*)(kbase + (size_t)(kt + NWAVES) * 32 * IDD + 16 * ks); }
        f32x16 sc;
#pragma unroll
        for (int i = 0; i < 16; ++i) sc[i] = 0.f;
        const LAS bf16* qb = Qs + q * QS_LD + 8 * h;
#pragma unroll 4
        for (int hd = 0; hd < NIH; ++hd) {
            f32x16 c;
#pragma unroll
            for (int i = 0; i < 16; ++i) c[i] = 0.f;
#pragma unroll
            for (int ks = 0; ks < 4; ++ks) { const bf16x8 b = *(const LAS bf16x8*)(qb + hd * IDD + 16 * ks); c = __builtin_amdgcn_mfma_f32_32x32x16_bf16(a[ks], b, c, 0, 0, 0); }
            const float wh = Ws[hd * 32 + q];
#pragma unroll
            for (int i = 0; i < 16; ++i) sc[i] += relu_(c[i]) * wh;
        }
        float* sp = (float*)(F.ws + WS_SCP) + (size_t)(qrow0 + q) * SEQ + kt * 32 + 4 * h;
#pragma unroll
        for (int a4 = 0; a4 < 4; ++a4) *(f32x4*)(sp + 8 * a4) = (f32x4){sc[4 * a4], sc[4 * a4 + 1], sc[4 * a4 + 2], sc[4 * a4 + 3]};
    }
}
__device__ __forceinline__ void idx_sample_item(Frame& F, int n, int kt_lo, int kt_hi) {
    const int lane = F.lane, q = lane & 31, h = lane >> 5;
    const bf16* QI = (const bf16*)(F.ws + WS_QI); const bf16* KI = (const bf16*)(F.ws + WS_KI); const float* WI = (const float*)(F.ws + WS_WI);
    bf16x8 qa[2][4]; f32x4 wr[2][4];
#pragma unroll
    for (int rt = 0; rt < 2; ++rt) { const bf16* qp = QI + (size_t)(TP + 4 * n + 2 * rt + (q >> 4)) * QIW + (q & 15) * IDD + 8 * h;
#pragma unroll
        for (int ks = 0; ks < 4; ++ks) qa[rt][ks] = *(const bf16x8*)(qp + 16 * ks);
#pragma unroll
        for (int a = 0; a < 4; ++a) wr[rt][a] = *(const f32x4*)(WI + (size_t)(TP + 4 * n + 2 * rt + (a >> 1)) * NIH + 8 * (a & 1) + 4 * h) * 0.03125f; }
    f32x4 cur[8], nxt[8];
    int kt = kt_lo + F.wave;
    if (kt < kt_hi && kt < PAST / 32) { const int pg = F.page_table[n * NPG + (kt >> 2)]; const float* kp = F.cache_ik + ((size_t)pg * PAGE + ((kt & 3) * 32 + q)) * IDD + 8 * h;
#pragma unroll
        for (int ks = 0; ks < 4; ++ks) { cur[2 * ks] = *(const f32x4*)(kp + 16 * ks); cur[2 * ks + 1] = *(const f32x4*)(kp + 16 * ks + 4); } }
    for (; kt < kt_hi; kt += NWAVES) {
        bf16x8 kf[4];
        const int ktn = kt + NWAVES; const bool pn = ktn < kt_hi && ktn < PAST / 32;
        if (pn) { const int pg = F.page_table[n * NPG + (ktn >> 2)]; const float* kp = F.cache_ik + ((size_t)pg * PAGE + ((ktn & 3) * 32 + q)) * IDD + 8 * h;
#pragma unroll
            for (int ks = 0; ks < 4; ++ks) { nxt[2 * ks] = *(const f32x4*)(kp + 16 * ks); nxt[2 * ks + 1] = *(const f32x4*)(kp + 16 * ks + 4); } }
        if (kt < PAST / 32) {
#pragma unroll
            for (int ks = 0; ks < 4; ++ks) { const f32x4 x0 = cur[2 * ks], x1 = cur[2 * ks + 1];
                v4u t; t.x = cvt_pk_bf16(x0.x, x0.y); t.y = cvt_pk_bf16(x0.z, x0.w); t.z = cvt_pk_bf16(x1.x, x1.y); t.w = cvt_pk_bf16(x1.z, x1.w); kf[ks] = __builtin_bit_cast(bf16x8, t); } }
        else { const int s = kt * 32 + q; const bf16* kp = KI + (size_t)(TP + 4 * n + ((s - PAST) & 3)) * IDD + 8 * h;
#pragma unroll
            for (int ks = 0; ks < 4; ++ks) kf[ks] = *(const bf16x8*)(kp + 16 * ks); }
#pragma unroll
        for (int rt = 0; rt < 2; ++rt) {
            f32x16 c;
#pragma unroll
            for (int i = 0; i < 16; ++i) c[i] = 0.f;
#pragma unroll
            for (int ks = 0; ks < 4; ++ks) c = __builtin_amdgcn_mfma_f32_32x32x16_bf16(qa[rt][ks], kf[ks], c, 0, 0, 0);
            float p0 = 0.f, p1 = 0.f;
#pragma unroll
            for (int i = 0; i < 8; ++i) { p0 += relu_(c[i]) * wr[rt][i >> 2][i & 3]; p1 += relu_(c[8 + i]) * wr[rt][2 + (i >> 2)][i & 3]; }
            p0 += __shfl_xor(p0, 32); p1 += __shfl_xor(p1, 32);
            float* sp = (float*)(F.ws + WS_SCS) + (size_t)(4 * n + 2 * rt + h) * SC_S_LD + kt * 32 + q;
            *sp = h ? p1 : p0;
        }
        if (pn) {
#pragma unroll
            for (int j = 0; j < 8; ++j) cur[j] = nxt[j]; }
    }
}
__device__ __forceinline__ void p3_indexer(Frame& F) {
    for (int it = F.vcu; it < 256; it += F.G) { const int b = it >> 7, x = it & 127, y = 127 - x;
        idx_item(F, b * SEQ + 32 * x, 0, (x + 2) >> 1);
        idx_item(F, b * SEQ + 32 * y, (y + 2) >> 1, y + 1); }
    __syncthreads();
    for (int it = F.vcu; it < 2 * NSEQ; it += F.G) { const int n = it >> 1, hf = it & 1; idx_sample_item(F, n, hf ? 33 : 0, hf ? 65 : 33); }
}

constexpr int AT_WAVE_LDS = 17920;
__device__ __forceinline__ void sample_copy(Frame& F, int m, int kvh) {
    int lane = fresh_lane(); asm volatile("" : "+v"(lane));
    const int half = lane >> 5, d0 = 4 * (lane & 31), nseq = (m - TP) >> 2;
    const unsigned* sel = (const unsigned*)(F.ws + WS_SEL) + (size_t)m * TOPK;
    unsigned char* kc = F.ws + WS_KC8 + ((size_t)(m - TP) * NKV + kvh) * (TOPK * HD);
    unsigned char* vc = F.ws + WS_VC8 + ((size_t)(m - TP) * NKV + kvh) * (TOPK * HD);
    const int kpos = ((d0 >> 3) & 3) * 32 + (d0 >> 5) * 8 + (d0 & 7);
    const bf16* KB = (const bf16*)(F.ws + WS_KB); const bf16* VB = (const bf16*)(F.ws + WS_VB);
    const v4u sl4 = *(const v4u*)(sel + 4 * lane);
#pragma unroll 1
    for (int p0 = 0; p0 < TOPK / 2; p0 += 16) {
        unsigned e[16]; f32x4 xk[16], xv[16];
#pragma unroll
        for (int i = 0; i < 16; ++i) { const int src = (p0 + i) >> 1;
            const unsigned r0 = (unsigned)__builtin_amdgcn_readlane((int)((i & 1) ? sl4.z : sl4.x), src), r1 = (unsigned)__builtin_amdgcn_readlane((int)((i & 1) ? sl4.w : sl4.y), src);
            e[i] = half ? r1 : r0; }
#pragma unroll
        for (int i = 0; i < 16; ++i) {
            if (e[i] < NEWFLAG) { const size_t ro = ((size_t)e[i] * NKV + kvh) * HD + d0; xk[i] = __builtin_nontemporal_load((const f32x4*)(F.cache_k + ro)); xv[i] = __builtin_nontemporal_load((const f32x4*)(F.cache_v + ro)); }
            else { const size_t ro = (size_t)(TP + 4 * nseq + (e[i] & 3u)) * KVW + kvh * HD + d0; const v2u a = *(const v2u*)(KB + ro), b = *(const v2u*)(VB + ro);
                xk[i] = (f32x4){__builtin_bit_cast(float, a.x << 16), __builtin_bit_cast(float, a.x & 0xffff0000u), __builtin_bit_cast(float, a.y << 16), __builtin_bit_cast(float, a.y & 0xffff0000u)};
                xv[i] = (f32x4){__builtin_bit_cast(float, b.x << 16), __builtin_bit_cast(float, b.x & 0xffff0000u), __builtin_bit_cast(float, b.y << 16), __builtin_bit_cast(float, b.y & 0xffff0000u)}; } }
#pragma unroll
        for (int i = 0; i < 16; ++i) { const int slot = 2 * (p0 + i) + half;
            int t = __builtin_amdgcn_cvt_pk_fp8_f32(xk[i][0], xk[i][1], 0, false); *(unsigned*)(kc + slot * HD + kpos) = (unsigned)__builtin_amdgcn_cvt_pk_fp8_f32(xk[i][2], xk[i][3], t, true);
            t = __builtin_amdgcn_cvt_pk_fp8_f32(xv[i][0], xv[i][1], 0, false); *(unsigned*)(vc + slot * HD + d0) = (unsigned)__builtin_amdgcn_cvt_pk_fp8_f32(xv[i][2], xv[i][3], t, true); }
    }
}
__device__ __forceinline__ int lane_count_total7(int cv) {
    int t = 0;
#pragma unroll
    for (int b = 0; b < 7; ++b) t += __popcll(__ballot((cv >> b) & 1)) << b;
    return t;
}
__device__ __forceinline__ int lane_count_total(int cv) {
    int t = 0;
#pragma unroll
    for (int b = 0; b < 5; ++b) t += __popcll(__ballot((cv >> b) & 1)) << b;
    return t;
}
struct TkSlot { bool att, smp; int j, m, nvalid; };
__device__ __forceinline__ TkSlot tk_decode(int slot, int nP, int nS, int wave, int gw, int NGW) {
    TkSlot t; int k;
    if (wave & 4) { t.smp = slot < 2 * nS; k = t.smp ? slot : slot - 2 * nS; } else { t.smp = slot >= nP; k = t.smp ? slot - nP : slot; }
    t.att = t.smp && (k & 1); if (t.smp) k >>= 1;
    t.j = gw + k * NGW;
    t.m = t.smp ? TP + (t.j >> 2) : (t.j & ~2047) + ((t.j >> 11) & 1 ? 2047 - (t.j & 2047) : (t.j & 2047));
    t.nvalid = t.smp ? PAST + 1 + ((t.m - TP) & 3) : (t.m & (SEQ - 1)) + 1;
    return t;
}
__device__ __forceinline__ const float* tk_scores(const Frame& F, const TkSlot& t) { return t.smp ? (const float*)(F.ws + WS_SCS) + (size_t)(t.m - TP) * SC_S_LD : (const float*)(F.ws + WS_SCP) + (size_t)t.m * SEQ; }
__device__ __forceinline__ void tk_load(float (&v)[64], const float* sp, int nvalid, int lane) {
    const int nreg = (nvalid + 63) >> 6;
#pragma unroll
    for (int i = 0; i < 64; ++i) { const int s = i * 64 + lane; const bool ok = i < nreg && s < nvalid; v[i] = ok ? sp[s] : -INFINITY; }
}
__device__ __forceinline__ void p4_topk(Frame& F) {
    const int gw = F.vcu * NWAVES + F.wave, NGW = F.G * NWAVES;
    unsigned* SEL = (unsigned*)(F.ws + WS_SEL); unsigned* CNT = (unsigned*)(F.ws + WS_CNT);
    const int nP = gw < TP ? (TP - gw + NGW - 1) / NGW : 0, nS = gw < TS * NKV ? (TS * NKV - gw + NGW - 1) / NGW : 0;
    LAS unsigned char* wl = F.lds + F.wave * AT_WAVE_LDS;
    bool pre = false;
#pragma unroll 1
    for (int slot = 0; slot < nP + 2 * nS; ++slot) {
        const TkSlot cur = tk_decode(slot, nP, nS, F.wave, gw, NGW);
        if (cur.att) { sample_copy(F, TP + (cur.j >> 2), cur.j & 3); continue; }
        int lane = fresh_lane(); asm volatile("" : "+v"(lane));
        const bool smp = cur.smp; const int m = cur.m, nvalid = cur.nvalid;
        unsigned* sel = SEL + (size_t)m * TOPK;
        if (nvalid <= TOPK) {
#pragma unroll
            for (int j = 0; j < 4; ++j) { const int s = lane + 64 * j; sel[s] = s < nvalid ? (unsigned)s : 0u; }
            if (lane == 0) CNT[m] = (unsigned)nvalid;
            continue;
        }
        const int nreg = (nvalid + 63) >> 6;
        float v[64];
        if (pre) {
#pragma unroll
            for (int i = 0; i < 64; ++i) { const int s_ = i * 64 + lane; v[i] = (i < nreg && s_ < nvalid) ? ((const LAS float*)wl)[s_] : -INFINITY; }
            LDS_WAIT();
        } else tk_load(v, tk_scores(F, cur), nvalid, lane);
        pre = false;
        {
            int ns = slot + 1; TkSlot nx = cur; bool have = false;
            if (ns < nP + 2 * nS) { nx = tk_decode(ns, nP, nS, F.wave, gw, NGW); if (nx.att) { ++ns; if (ns < nP + 2 * nS) { nx = tk_decode(ns, nP, nS, F.wave, gw, NGW); have = true; } } else have = true; }
            if (have && !nx.att && nx.nvalid > TOPK) { const float* np_ = tk_scores(F, nx) + 4 * lane; const int nch = (nx.nvalid + 255) >> 8;
#pragma unroll
                for (int c = 0; c < 16; ++c) if (c < nch) __builtin_amdgcn_global_load_lds((const unsigned*)(np_ + c * 256), (LAS unsigned*)(wl + c * 1024), 16, 0, 0);
                pre = true; } }
        float mx = -INFINITY, mn = INFINITY;
#pragma unroll
        for (int i = 0; i < 64; ++i) { const int s = i * 64 + lane; const bool ok = s < nvalid; mx = fmaxf(mx, v[i]); mn = ok ? fminf(mn, v[i]) : mn; }
#pragma unroll
        for (int o = 1; o < 64; o <<= 1) { mx = fmaxf(mx, __shfl_xor(mx, o)); mn = fminf(mn, __shfl_xor(mn, o)); }
        float flo = mn, fhi = __builtin_bit_cast(float, __builtin_bit_cast(unsigned, mx) + (mx >= 0.f ? 1u : 0xffffffffu));
        if (mx == 0.f) fhi = 1e-30f;
        float tau = flo; bool exact = false;
        for (int it = 0; it < 200; ++it) {
            const float mid = 0.5f * flo + 0.5f * fhi;
            if (!(mid > flo && mid < fhi)) break;
            unsigned b0 = 0u, b1 = 0u;
#pragma unroll
            for (int blk = 0; blk < 4; ++blk) if (blk * 16 < nreg) {
#pragma unroll
                for (int i = 0; i < 16; ++i) { const int ii = blk * 16 + i; const unsigned d = __builtin_bit_cast(unsigned, v[ii] - mid);
                    if (blk < 2) b0 = __builtin_amdgcn_alignbit(b0, d, 31); else b1 = __builtin_amdgcn_alignbit(b1, d, 31); } }
            const int nproc = nreg > 48 ? 64 : (nreg > 32 ? 48 : (nreg > 16 ? 32 : 16));
            const int c = nproc * 64 - lane_count_total7(__popc(b0) + __popc(b1));
            if (c == TOPK) { tau = mid; exact = true; break; }
            if (c > TOPK) flo = mid; else fhi = mid;
            tau = flo;
        }
        int base = 0;
        const int n0 = smp ? (m - TP) >> 2 : 0;
        typedef int i32x16 __attribute__((ext_vector_type(16)));
        i32x16 pgv = (i32x16)(0);
        if (smp) { const int* ptb = F.page_table + n0 * NPG; asm volatile("s_load_dwordx16 %0, %1, 0x0\n\ts_waitcnt lgkmcnt(0)" : "=s"(pgv) : "s"(ptb) : "memory"); }
        float taux = tau;
        if (!exact) { const unsigned tb = __builtin_bit_cast(unsigned, tau); taux = (tau == 0.f) ? __builtin_bit_cast(float, 1u) : __builtin_bit_cast(float, tau > 0.f ? tb + 1u : tb - 1u); }
#pragma unroll
        for (int blk = 0; blk < 4; ++blk) if (blk * 16 < nreg) {
#pragma unroll
            for (int i = 0; i < 16; ++i) { const int ii = blk * 16 + i; const bool s_ = v[ii] >= taux;
                const unsigned long long mk = __ballot(s_); const int pos = base + __builtin_amdgcn_mbcnt_hi((unsigned)(mk >> 32), __builtin_amdgcn_mbcnt_lo((unsigned)mk, 0u));
                if (s_) { const int s = ii * 64 + lane; unsigned e = (unsigned)s;
                    if (smp) e = ii < PAST / 64 ? (unsigned)pgv[(ii >> 1) & 15] * PAGE + (s & 127) : NEWFLAG + (unsigned)(s - PAST);
                    sel[pos] = e; }
                base += __popcll(mk); } }
        if (!exact) {
#pragma unroll
            for (int blk = 0; blk < 4; ++blk) if (blk * 16 < nreg) {
#pragma unroll
                for (int i = 0; i < 16; ++i) { const int ii = blk * 16 + i; const bool s_ = v[ii] == tau;
                    const unsigned long long mk = __ballot(s_); const int pos = base + __builtin_amdgcn_mbcnt_hi((unsigned)(mk >> 32), __builtin_amdgcn_mbcnt_lo((unsigned)mk, 0u));
                    if (s_ && pos < TOPK) { const int s = ii * 64 + lane; unsigned e = (unsigned)s;
                        if (smp) e = ii < PAST / 64 ? (unsigned)pgv[(ii >> 1) & 15] * PAGE + (s & 127) : NEWFLAG + (unsigned)(s - PAST);
                        sel[pos] = e; }
                    base += __popcll(mk); } }
        }
        if (lane == 0) CNT[m] = TOPK;
        if (smp) { VM_WAIT(); } asm volatile("" ::: "memory");
    }
}

#define AT_WAITV(n) asm volatile("s_waitcnt vmcnt(" #n ")" ::: "memory")
__device__ __forceinline__ void at_issue_tile(const char* kb, const char* vb, unsigned rstride, unsigned ilb, LAS unsigned char* ringp, int j, int lane) {
    const unsigned q = (unsigned)lane >> 3, p8 = (unsigned)lane & 7u;
    unsigned a0 = ilb + 2u * (j < 8 ? (unsigned)(32 * j) + q : (unsigned)((2 * (j - 8) + (int)(q >> 2)) * 16) + (q & 3u)); asm volatile("" : "+v"(a0));
    unsigned e0, e1, e2, e3;
    if (j < 8) asm volatile("ds_read_u16 %0, %4\n\tds_read_u16 %1, %4 offset:16\n\tds_read_u16 %2, %4 offset:32\n\tds_read_u16 %3, %4 offset:48\n\ts_waitcnt lgkmcnt(0)"
                            : "=&v"(e0), "=&v"(e1), "=&v"(e2), "=&v"(e3) : "v"(a0) : "memory");
    else       asm volatile("ds_read_u16 %0, %4\n\tds_read_u16 %1, %4 offset:8\n\tds_read_u16 %2, %4 offset:16\n\tds_read_u16 %3, %4 offset:24\n\ts_waitcnt lgkmcnt(0)"
                            : "=&v"(e0), "=&v"(e1), "=&v"(e2), "=&v"(e3) : "v"(a0) : "memory");
    const unsigned e[4] = {e0, e1, e2, e3};
#pragma unroll
    for (int i = 0; i < 4; ++i) {
        const unsigned ch = p8 ^ ((4u * (unsigned)i + (q >> 1)) & 7u);
        const char* src = (j < 8 ? kb : vb) + (e[i] * rstride + 16u * ch);
        __builtin_amdgcn_global_load_lds((const unsigned*)src, (LAS unsigned*)(ringp + (j & 3) * 4096 + i * 1024), 16, 0, 0);
    }
}
__device__ __forceinline__ void at_idx_issue(unsigned ilb, int j, int lane, unsigned& e0, unsigned& e1, unsigned& e2, unsigned& e3) {
    const unsigned q = (unsigned)lane >> 3;
    unsigned a0 = ilb + 2u * (j < 8 ? (unsigned)(32 * j) + q : (unsigned)((2 * (j - 8) + (int)(q >> 2)) * 16) + (q & 3u)); asm volatile("" : "+v"(a0));
    if (j < 8) asm volatile("ds_read_u16 %0, %4\n\tds_read_u16 %1, %4 offset:16\n\tds_read_u16 %2, %4 offset:32\n\tds_read_u16 %3, %4 offset:48"
                            : "=&v"(e0), "=&v"(e1), "=&v"(e2), "=&v"(e3) : "v"(a0) : "memory");
    else       asm volatile("ds_read_u16 %0, %4\n\tds_read_u16 %1, %4 offset:8\n\tds_read_u16 %2, %4 offset:16\n\tds_read_u16 %3, %4 offset:24"
                            : "=&v"(e0), "=&v"(e1), "=&v"(e2), "=&v"(e3) : "v"(a0) : "memory");
}
__device__ __forceinline__ void at_dma(const char* kb, const char* vb, unsigned rstride, LAS unsigned char* ringp, int j, int lane, unsigned e0, unsigned e1, unsigned e2, unsigned e3) {
    const unsigned q = (unsigned)lane >> 3, p8 = (unsigned)lane & 7u;
    const unsigned e[4] = {e0, e1, e2, e3};
#pragma unroll
    for (int i = 0; i < 4; ++i) {
        const unsigned ch = p8 ^ ((4u * (unsigned)i + (q >> 1)) & 7u);
        const char* src = (j < 8 ? kb : vb) + (e[i] * rstride + 16u * ch);
        __builtin_amdgcn_global_load_lds((const unsigned*)src, (LAS unsigned*)(ringp + (j & 3) * 4096 + i * 1024), 16, 0, 0);
    }
}
__device__ __forceinline__ long q_to_fp8(const bf16x8 qv) { const v4u w = __builtin_bit_cast(v4u, qv);
    int t = __builtin_amdgcn_cvt_pk_fp8_f32(__builtin_bit_cast(float, w.x << 16), __builtin_bit_cast(float, w.x & 0xffff0000u), 0, false);
    const unsigned lo = (unsigned)__builtin_amdgcn_cvt_pk_fp8_f32(__builtin_bit_cast(float, w.y << 16), __builtin_bit_cast(float, w.y & 0xffff0000u), t, true);
    t = __builtin_amdgcn_cvt_pk_fp8_f32(__builtin_bit_cast(float, w.z << 16), __builtin_bit_cast(float, w.z & 0xffff0000u), 0, false);
    const unsigned hi = (unsigned)__builtin_amdgcn_cvt_pk_fp8_f32(__builtin_bit_cast(float, w.w << 16), __builtin_bit_cast(float, w.w & 0xffff0000u), t, true);
    return (long)(((unsigned long long)hi << 32) | lo); }
__device__ __forceinline__ void attn_stream(Frame& F, int m0, int kvh, int count, LAS unsigned char* wl, bool sample) {
    if (count <= 0) return;
    int lane_ = fresh_lane(); asm volatile("" : "+v"(lane_));
    const int lane = lane_, r16 = lane & 15, g = lane >> 4;
    const bf16* Q = (const bf16*)(F.ws + WS_Q);
    const unsigned* SEL = sample ? (const unsigned*)(F.ws + WS_IDENT) - (size_t)m0 * TOPK : (const unsigned*)(F.ws + WS_SEL);
    const size_t pbase = (size_t)(m0 & ~(SEQ - 1));
    const char* kb = sample ? (const char*)(F.ws + WS_KC8) + ((size_t)(m0 - TP) * NKV + kvh) * (TOPK * HD) : (const char*)(F.ws + WS_K8) + pbase * KVW + kvh * HD;
    const char* vb = sample ? (const char*)(F.ws + WS_VC8) + ((size_t)(m0 - TP) * NKV + kvh) * (TOPK * HD) : (const char*)(F.ws + WS_V8) + pbase * KVW + kvh * HD;
    const unsigned rstride = sample ? (unsigned)HD : (unsigned)KVW;
    const unsigned wlb = (unsigned)(size_t)wl, ringb = wlb + 1024u;
    LAS unsigned char* ringp = wl + 1024;
    const unsigned kx = ((unsigned)r16 >> 1) & 7u;
    const unsigned kl = ringb + 128u * (unsigned)r16 + 16u * ((2u * (unsigned)g) ^ kx);
    const unsigned vr = 8u * (unsigned)g + (((unsigned)lane & 15u) >> 1), vx = (vr >> 1) & 7u;
    const unsigned vl = ringb + 128u * vr + 8u * ((unsigned)lane & 1u);
    long q8[4]; bf16x8 qn[4]; v4u seln;
    { const v4u s4 = *(const v4u*)(SEL + (size_t)m0 * TOPK + 4 * lane);
      v2u pk; pk.x = (s4.x & 0xffffu) | (s4.y << 16); pk.y = (s4.z & 0xffffu) | (s4.w << 16);
      asm volatile("ds_write_b64 %0, %1\n\ts_waitcnt lgkmcnt(0)" :: "v"(wlb + 8u * lane), "v"(pk) : "memory");
      const bf16* qp = Q + (size_t)m0 * AW + (kvh * 4 + (r16 & 3)) * HD + 8 * g;
#pragma unroll
      for (int ks = 0; ks < 4; ++ks) q8[ks] = q_to_fp8(*(const bf16x8*)(qp + 32 * ks)); }
    at_issue_tile(kb, vb, rstride, wlb, ringp, 0, lane); at_issue_tile(kb, vb, rstride, wlb, ringp, 1, lane); at_issue_tile(kb, vb, rstride, wlb, ringp, 2, lane);
    for (int k = 0; k < count; ++k) {
        const int m = m0 + k; const bool has_next = k + 1 < count;
        const unsigned ilb = wlb + 512u * (k & 1), iln = wlb + 512u * ((k + 1) & 1);
        const unsigned cnt = (!sample && (unsigned)((m & (SEQ - 1)) + 1) < (unsigned)TOPK) ? (unsigned)((m & (SEQ - 1)) + 1) : (unsigned)TOPK;
        f32x4 S[16], O[8];
#pragma unroll
        for (int c = 0; c < 8; ++c) O[c] = (f32x4){0.f, 0.f, 0.f, 0.f};
        float sum = 0.f;
#pragma clang loop unroll(full)
        for (int j = 0; j < 16; ++j) {
            if (j == 14) { if (has_next) AT_WAITV(8); else AT_WAITV(4); }
            else if (j == 15) { if (has_next) AT_WAITV(8); else AT_WAITV(0); }
            else AT_WAITV(8);
            unsigned e0 = 0u, e1 = 0u, e2 = 0u, e3 = 0u;
            if (j + 3 < 16) at_idx_issue(ilb, j + 3, lane, e0, e1, e2, e3);
            else if (has_next) at_idx_issue(iln, j + 3 - 16, lane, e0, e1, e2, e3);
            if (j < 8) {
#pragma unroll
                for (int sub = 0; sub < 2; ++sub) {
                    unsigned ab = kl + (unsigned)(j & 3) * 4096u + 2048u * sub; asm volatile("" : "+v"(ab));
                    v4u a0, a1;
                    asm volatile("ds_read_b128 %0, %6\n\tds_read_b128 %1, %7\n\ts_waitcnt lgkmcnt(0)" : "=&v"(a0), "=&v"(a1), "+v"(e0), "+v"(e1), "+v"(e2), "+v"(e3) : "v"(ab), "v"(ab ^ 16u) : "memory");
                    f32x4 c = (f32x4){0.f, 0.f, 0.f, 0.f};
                    c = __builtin_amdgcn_mfma_f32_16x16x32_fp8_fp8((long)(((unsigned long long)a0.y << 32) | a0.x), q8[0], c, 0, 0, 0);
                    c = __builtin_amdgcn_mfma_f32_16x16x32_fp8_fp8((long)(((unsigned long long)a0.w << 32) | a0.z), q8[1], c, 0, 0, 0);
                    c = __builtin_amdgcn_mfma_f32_16x16x32_fp8_fp8((long)(((unsigned long long)a1.y << 32) | a1.x), q8[2], c, 0, 0, 0);
                    c = __builtin_amdgcn_mfma_f32_16x16x32_fp8_fp8((long)(((unsigned long long)a1.w << 32) | a1.z), q8[3], c, 0, 0, 0);
                    S[2 * j + sub] = c;
                }
                if (j == 7) {
                    constexpr float SCL = 0.08838834764831845f * 1.4426950408889634f;
                    if (cnt < (unsigned)TOPK) {
#pragma unroll
                        for (int kt = 0; kt < 16; ++kt)
#pragma unroll
                            for (int i = 0; i < 4; ++i) { const unsigned slot = kt * 16 + 4 * g + i; S[kt][i] = slot < cnt ? S[kt][i] : -INFINITY; } }
                    float mx = -INFINITY;
#pragma unroll
                    for (int kt = 0; kt < 16; ++kt)
#pragma unroll
                        for (int i = 0; i < 4; ++i) mx = fmaxf(mx, S[kt][i]);
                    mx = fmaxf(mx, __shfl_xor(mx, 16)); mx = fmaxf(mx, __shfl_xor(mx, 32));
                    const float nm = -mx * SCL;
#pragma unroll
                    for (int kt = 0; kt < 16; ++kt)
#pragma unroll
                        for (int i = 0; i < 4; ++i) { const float p = __builtin_amdgcn_exp2f(__builtin_fmaf(S[kt][i], SCL, nm)); S[kt][i] = p; sum += p; }
                    sum += __shfl_xor(sum, 16); sum += __shfl_xor(sum, 32);
                }
            } else {
                const int ks = j - 8;
                int t = __builtin_amdgcn_cvt_pk_fp8_f32(S[2 * ks][0], S[2 * ks][1], 0, false); const unsigned plo = (unsigned)__builtin_amdgcn_cvt_pk_fp8_f32(S[2 * ks][2], S[2 * ks][3], t, true);
                t = __builtin_amdgcn_cvt_pk_fp8_f32(S[2 * ks + 1][0], S[2 * ks + 1][1], 0, false); const unsigned phi = (unsigned)__builtin_amdgcn_cvt_pk_fp8_f32(S[2 * ks + 1][2], S[2 * ks + 1][3], t, true);
                const long pf = (long)(((unsigned long long)phi << 32) | plo);
                unsigned vtb = vl + (unsigned)(j & 3) * 4096u; asm volatile("" : "+v"(vtb));
                v2u b[8];
                asm volatile("ds_read_b64_tr_b8 %0, %8\n\tds_read_b64_tr_b8 %1, %9\n\tds_read_b64_tr_b8 %2, %10\n\tds_read_b64_tr_b8 %3, %11\n\t"
                             "ds_read_b64_tr_b8 %4, %12\n\tds_read_b64_tr_b8 %5, %13\n\tds_read_b64_tr_b8 %6, %14\n\tds_read_b64_tr_b8 %7, %15\n\ts_waitcnt lgkmcnt(0)"
                             : "=&v"(b[0]), "=&v"(b[1]), "=&v"(b[2]), "=&v"(b[3]), "=&v"(b[4]), "=&v"(b[5]), "=&v"(b[6]), "=&v"(b[7])
                             : "v"(vtb + 16u * (0u ^ vx)), "v"(vtb + 16u * (1u ^ vx)), "v"(vtb + 16u * (2u ^ vx)), "v"(vtb + 16u * (3u ^ vx)),
                               "v"(vtb + 16u * (4u ^ vx)), "v"(vtb + 16u * (5u ^ vx)), "v"(vtb + 16u * (6u ^ vx)), "v"(vtb + 16u * (7u ^ vx)) : "memory");
                asm volatile("" : "+v"(e0), "+v"(e1), "+v"(e2), "+v"(e3));
#pragma unroll
                for (int c = 0; c < 8; ++c) O[c] = __builtin_amdgcn_mfma_f32_16x16x32_fp8_fp8(pf, (long)(((unsigned long long)b[c].y << 32) | b[c].x), O[c], 0, 0, 0);
            }
            if (j == 4 && has_next) {
                seln = *(const v4u*)(SEL + (size_t)(m + 1) * TOPK + 4 * lane);
                const bf16* qp = Q + (size_t)(m + 1) * AW + (kvh * 4 + (r16 & 3)) * HD + 8 * g;
#pragma unroll
                for (int ks = 0; ks < 4; ++ks) qn[ks] = *(const bf16x8*)(qp + 32 * ks);
            }
            if (j == 12 && has_next) {
                v2u pk; pk.x = (seln.x & 0xffffu) | (seln.y << 16); pk.y = (seln.z & 0xffffu) | (seln.w << 16);
                asm volatile("ds_write_b64 %0, %1\n\ts_waitcnt lgkmcnt(0)" :: "v"(iln + 8u * lane), "v"(pk) : "memory");
            }
            if (j + 3 < 16) at_dma(kb, vb, rstride, ringp, j + 3, lane, e0, e1, e2, e3);
            else if (has_next) at_dma(kb, vb, rstride, ringp, j + 3 - 16, lane, e0, e1, e2, e3);
        }
        float inv[4];
#pragma unroll
        for (int i = 0; i < 4; ++i) inv[i] = 1.0f / __shfl(sum, i);
        const unsigned ob = ringb + 3u * 4096u;
        if (g == 0) {
#pragma unroll
            for (int c = 0; c < 8; ++c)
#pragma unroll
                for (int i = 0; i < 4; ++i) { const unsigned hv = cvt_pk_bf16(O[c][i] * inv[i], 0.f);
                    asm volatile("ds_write_b16 %0, %1" :: "v"(ob + 2u * (unsigned)(i * HD + 16 * c + r16)), "v"(hv) : "memory"); }
        }
        v4u ov;
        asm volatile("s_waitcnt lgkmcnt(0)\n\tds_read_b128 %0, %1\n\ts_waitcnt lgkmcnt(0)" : "=&v"(ov) : "v"(ob + 16u * lane) : "memory");
        *(v4u*)((bf16*)(F.ws + WS_PA) + (size_t)m * 3072 + PW + (kvh * 4) * HD + 8 * lane) = ov;
        if (has_next) {
#pragma unroll
            for (int ks = 0; ks < 4; ++ks) q8[ks] = q_to_fp8(qn[ks]); }
    }
    AT_WAITV(0);
}
__device__ __forceinline__ void p5_attention(Frame& F) {
    const int gw = F.vcu * NWAVES + F.wave, NGW = F.G * NWAVES;
    LAS unsigned char* wl = F.lds + F.wave * AT_WAVE_LDS;
    const int per = (NB * NKV * SEQ + NGW - 1) / NGW;
    const int i0 = gw * per, i1 = (i0 + per) < NB * NKV * SEQ ? (i0 + per) : NB * NKV * SEQ;
    const int n = i1 > i0 ? i1 - i0 : 0;
    const bool streamable = (SEQ % per) == 0;
    const int step = streamable ? n : 1;
#pragma unroll 1
    for (int rep2 = 0; rep2 < PROBE_STREAM_REPS; ++rep2)
#pragma unroll 1
    for (int q = i0; q < i0 + n + 1; q += step) {
        if (q < i0 + n) attn_stream(F, ((q >> 12) >> 2) * SEQ + (q & (SEQ - 1)), (q >> 12) & 3, step, wl, false);
        else for (int idx = gw; idx < TS * NKV; idx += NGW) attn_stream(F, TP + (idx >> 2), idx & 3, 1, wl, true);
        if (q >= i0 + n) break; }
}

constexpr int NPHASE = 13;
__global__ void __launch_bounds__(NWAVES * 64, 2) fwd(Args args) {
    extern __shared__ __attribute__((aligned(16))) unsigned char lds[];
    Frame F;
    F.lds = (LAS unsigned char*)lds;
    F.tid = threadIdx.x; F.lane = F.tid & 63; F.wave = __builtin_amdgcn_readfirstlane(F.tid >> 6);
    F.G = gridDim.x; { const int bx = blockIdx.x; F.vcu = (F.G % 8 == 0) ? (bx % 8) * (F.G / 8) + bx / 8 : bx; }
    F.xp = args.in[0]; F.xs = args.in[1]; F.cache_k = args.in[2]; F.cache_v = args.in[3]; F.cache_ik = args.in[4]; F.state_pool = args.in[5];
    F.cp = args.in[7]; F.cs = args.in[8]; F.w_ada = args.in[9]; F.b_ada = args.in[10]; F.g1 = args.in[11]; F.w_in = args.in[12]; F.w_grp = args.in[13]; F.pool_scale = args.in[14];
    F.w_up_pool = args.in[15]; F.w_up_attn = args.in[16]; F.w_out = args.in[17]; F.g2 = args.in[18]; F.w_ffn_in = args.in[19]; F.w_ffn_out = args.in[20]; F.g_final = args.in[21];
    F.page_table = args.page_table; F.out = args.out; F.ws = args.ws;
    volatile LAS unsigned* MISC = (volatile LAS unsigned*)(F.lds + MISC_OFF);
    for (int u = F.tid; u < (LDS_BYTES - MISC_OFF) / 4; u += NWAVES * 64) MISC[u] = 0u;
    __syncthreads();
    unsigned* ctl = (unsigned*)(F.ws + WS_CTL);
    XcdBarrier bar; bar.bar = ctl + CW_BAR; bar.x = 0; bar.st = nullptr;
    if (!MK_MULTI) bar = xcd_barrier_post(ctl + CW_BAR, MISC + 8, F.tid == 0);
    const int lo = args.ph_lo, hi = args.ph_hi;
#ifndef PH_MASK
#define PH_MASK 0x1fff
#endif

#ifndef DUP_MASK
#define DUP_MASK 0
#endif
#define IN(k) (((PH_MASK >> (k)) & 1) && lo <= (k) && (k) < hi)
#define REP(k) for (int rep_ = 0; rep_ < (((DUP_MASK >> (k)) & 1) ? 2 : 1); ++rep_)
#define FRESH() do { int l_ = fresh_lane(); asm volatile("" : "+v"(l_)); F.lane = l_; F.tid = F.wave * 64 + l_; } while (0)
#define SEAM(k) do { if (IN(k) && IN((k) + 1)) { FRESH(); xcd_barrier(bar, F.tid == 0); } FRESH(); } while (0)
    const int gw = F.vcu * NWAVES + F.wave, NGW = F.G * NWAVES;
    float* MODS = (float*)(F.ws + WS_MODS); bf16* U = (bf16*)(F.ws + WS_U); float* H = (float*)(F.ws + WS_H);
    bf16* HB = (bf16*)(F.ws + WS_Q);

    if (IN(0)) REP(0) { p0_prologue(F); } SEAM(0);
    if (IN(1)) REP(1) { p1_adaln(F); } SEAM(1);
    if (IN(2)) REP(2) {
        const int chunk = (TP + NGW - 1) / NGW, r0 = gw * chunk, r1 = r0 + chunk < TP ? r0 + chunk : TP;
        mod_rows<false>(F, F.xp, r0, r1, 0, F.g1, 0, U, F.lane);
        { const int sch = (TS + NGW - 1) / NGW, s0 = gw * sch, s1 = s0 + sch < TS ? s0 + sch : TS; mod_rows<false>(F, F.xs, s0, s1, TP, F.g1, 0, U, F.lane); }
    } SEAM(2);
    if (IN(3)) REP(3) {
        pg8::Gemm g{U, (const bf16*)(F.ws + WS_W1T)}; pg8::StaticOrder S; S.init(MR, N1, F.G, (int)blockIdx.x);
        EpiIn E{0, F.out, (float*)(F.ws + WS_PIN), (bf16*)(F.ws + WS_Q), (bf16*)(F.ws + WS_KB), (bf16*)(F.ws + WS_VB), (bf16*)(F.ws + WS_QI), (bf16*)(F.ws + WS_GA), (bf16*)(F.ws + WS_GB), (bf16*)(F.ws + WS_KI), (float*)(F.ws + WS_WI), F.ws + WS_K8, F.ws + WS_V8};
        pg8::gemm_phase<EpiIn, pg8::Shape<D, D, D, 0>>(F.lds, g, S, E, F.wave, F.lane);
    } SEAM(3);
    if (IN(4)) REP(4) { p3_pool_d(F); FRESH(); p3_indexer(F); } SEAM(4);
    if (IN(5)) REP(5) {
        pg8::Gemm g{(const bf16*)(F.ws + WS_DG), (const bf16*)(F.ws + WS_WGT)}; pg8::StaticOrder S; S.init(MR, PW, F.G, (int)blockIdx.x);
        EpiPool E{0, (bf16*)(F.ws + WS_PA), F.pool_scale};
        pg8::gemm_phase<EpiPool, pg8::Shape<PG, PG, PG, (size_t)MR * PG * 2>>(F.lds, g, S, E, F.wave, F.lane);
        FRESH(); p4_topk(F);
    } SEAM(5);
    if (IN(6)) REP(6) { p5_attention(F); } SEAM(6);
    float* SLAB_A = (float*)(F.ws + WS_SCP);
    if (IN(7)) REP(7) {
        pg8::StaticOrder S; S.init(TP, D, F.G, (int)blockIdx.x);
        { pg8::Gemm g{(const bf16*)(F.ws + WS_PA), (const bf16*)(F.ws + WS_WUPT)};
          EpiMixFused E{0, (const bf16*)(F.ws + WS_GA), (const bf16*)(F.ws + WS_GB), (bf16*)(F.ws + WS_MIX)};
          pg8::gemm_phase<EpiMixFused, pg8::Shape<3072, 3072, 3072, 0>>(F.lds, g, S, E, F.wave, F.lane); }
        { FRESH();
          const int w = F.wave, s0 = w < 2 ? 8 * w : (w < 4 ? 16 + 6 * (w - 2) : 28 + 5 * (w - 4)), ns = w < 2 ? 8 : (w < 4 ? 6 : 5);
          SgMix E{(const bf16*)(F.ws + WS_GA), (const bf16*)(F.ws + WS_GB), (bf16*)(F.ws + WS_MIX)};
          sample_gemm(F, (const bf16*)(F.ws + WS_PA) + (size_t)TP * 3072, 3072, (const bf16*)(F.ws + WS_WUPT), 3072, s0, ns, E); }
    } SEAM(7);
    if (IN(8)) REP(8) {
        { pg8::Gemm g{(const bf16*)(F.ws + WS_MIX), (const bf16*)(F.ws + WS_WOUTT)}; pg8::StaticOrder S; S.init(TP, D, F.G, (int)blockIdx.x);
          EpiRes<false, true> E{0, F.xp, F.xs, H, MODS, 2 * D, HB, HB};
          pg8::gemm_phase<EpiRes<false, true>, pg8::Shape<D, D, D, 0>>(F.lds, g, S, E, F.wave, F.lane); }
        { FRESH(); SgRes E{F.xs, HB, MODS, 2 * D};
          sample_gemm(F, (const bf16*)(F.ws + WS_MIX) + (size_t)TP * D, D, (const bf16*)(F.ws + WS_WOUTT), D, F.wave * (D / 64 / NWAVES), D / 64 / NWAVES, E); }
    } SEAM(8);
    if (IN(9)) REP(9) {
        { const int sch = (TS + NGW - 1) / NGW, s0 = gw * sch, s1 = s0 + sch < TS ? s0 + sch : TS; mod_rows<true>(F, HB + (size_t)TP * D, s0, s1, TP, F.g2, 3 * D, U, F.lane); }
        { const int chunk = (TP + NGW - 1) / NGW, r0 = gw * chunk, r1 = r0 + chunk < TP ? r0 + chunk : TP; mod_rows<true>(F, HB, r0, r1, 0, F.g2, 3 * D, U, F.lane); }
    } SEAM(9);
    if (IN(10)) REP(10) {
        pg8::Gemm g{U, (const bf16*)(F.ws + WS_WFIT)}; pg8::StaticOrder S; S.init(MR, 2 * DFF, F.G, (int)blockIdx.x);
        EpiFfn E{0, (bf16*)(F.ws + WS_ACT)};
        pg8::gemm_phase<EpiFfn, pg8::Shape<D, D, D, 0>>(F.lds, g, S, E, F.wave, F.lane);
    } SEAM(10);
    if (IN(11)) {
        { pg8::Gemm g{(const bf16*)(F.ws + WS_ACT), (const bf16*)(F.ws + WS_WFOT)}; pg8::StaticOrder S; S.init(TP, D, F.G, (int)blockIdx.x);
          EpiRes<true, false> E{0, H, H + (size_t)TP * D, H, MODS, 5 * D, HB, HB};
          pg8::gemm_phase<EpiRes<true, false>, pg8::Shape<DFF, DFF, DFF, 0>>(F.lds, g, S, E, F.wave, F.lane); }
        { pg8::Gemm g{(const bf16*)(F.ws + WS_ACT), (const bf16*)(F.ws + WS_WFOT)}; pg8::SplitOrder SS{TP / 256, TS / 256, D / 256, 11, F.G, (int)blockIdx.x};
          EpiSlab<false> E{0, SLAB_A, nullptr, nullptr, 0};
          pg8::gemm_phase<EpiSlab<false>, pg8::Shape<512, DFF, DFF, 0>, pg8::SplitOrder>(F.lds, g, SS, E, F.wave, F.lane); }
    } SEAM(11);
    if (IN(12)) REP(12) {
        { LAS float* red = (LAS float*)F.lds; int par = 0;
          for (int r = F.vcu; r < TS; r += F.G, par ^= 1) { const int m = TP + r; float rstd;
            const f32x4 v = coop_row<11, true>(F, HB + (size_t)m * D, SLAB_A + (size_t)r * D, MODS + (size_t)bidx_of(m) * NADA + 5 * D, red + 8 * par, rstd);
            const int c = 256 * F.wave + 4 * F.lane; *(f32x4*)(F.out + OUT_Y + (size_t)m * D + c) = v * rstd * *(const f32x4*)(F.g_final + c); } }
        { const int chunk = (TP + NGW - 1) / NGW, r0 = gw * chunk, r1 = r0 + chunk < TP ? r0 + chunk : TP;
          if (r0 < r1) { f32x4 cur[8], nx[8], Gf[8];
            row_load(cur, H + (size_t)r0 * D, F.lane);
#pragma unroll
            for (int j = 0; j < 8; ++j) Gf[j] = *(const f32x4*)(F.g_final + 4 * F.lane + 256 * j);
            for (int r = r0; r < r1; ++r) { const bool more = r + 1 < r1;
                if (more) row_load(nx, H + (size_t)(r + 1) * D, F.lane);
                const float rstd = row_rstd(cur); float* orow = F.out + OUT_Y + (size_t)r * D;
#pragma unroll
                for (int j = 0; j < 8; ++j) *(f32x4*)(orow + 4 * F.lane + 256 * j) = cur[j] * rstd * Gf[j];
                if (more) {
#pragma unroll
                    for (int j = 0; j < 8; ++j) cur[j] = nx[j]; } } } }
    }
#undef IN
#undef SEAM
}

extern "C" void kernel_launch(void* const* d_in, const int* in_sizes, int n_in, void* d_out, int out_size, void* d_ws, size_t ws_size, hipStream_t stream) {
    static int grid = 0;
    if (grid == 0) {
        if (n_in != 22 || (size_t)out_size != OUT_END || ws_size < WS_END) { fprintf(stderr, "kernel_launch: unexpected shapes (n_in %d, out %d, ws %zu, need %zu)\n", n_in, out_size, ws_size, (size_t)WS_END); grid = -1; return; }
        int dev = 0, cus = 0, per_cu = 0;
        if (hipGetDevice(&dev) != hipSuccess || hipDeviceGetAttribute(&cus, hipDeviceAttributeMultiprocessorCount, dev) != hipSuccess) { grid = -1; return; }
        if (hipFuncSetAttribute((const void*)fwd, hipFuncAttributeMaxDynamicSharedMemorySize, LDS_BYTES) != hipSuccess) { fprintf(stderr, "kernel_launch: hipFuncSetAttribute failed\n"); grid = -1; return; }
        if (hipOccupancyMaxActiveBlocksPerMultiprocessor(&per_cu, (const void*)fwd, NWAVES * 64, LDS_BYTES) != hipSuccess || per_cu < 1) fprintf(stderr, "kernel_launch: occupancy query says %d\n", per_cu);
        (void)hipGetLastError();
        grid = cus;
    }
    if (grid < 0) return;
    (void)hipMemsetAsync((char*)d_ws + WS_CTL, 0, CTL_ZERO_BYTES, stream);
    Args a{};
    for (int i = 0; i < 22; ++i) a.in[i] = (const float*)d_in[i];
    a.page_table = (const int*)d_in[6]; a.out = (float*)d_out; a.ws = (unsigned char*)d_ws;
#if MK_MULTI
    for (int p = 0; p < NPHASE; ++p) { a.ph_lo = p; a.ph_hi = p + 1; hipLaunchKernelGGL(fwd, dim3(grid), dim3(NWAVES * 64), LDS_BYTES, stream, a); }
#else
    a.ph_lo = 0; a.ph_hi = NPHASE; hipLaunchKernelGGL(fwd, dim3(grid), dim3(NWAVES * 64), LDS_BYTES, stream, a);
#endif
    const hipError_t le = hipPeekAtLastError();
    if (le != hipSuccess) fprintf(stderr, "kernel_launch: launch failed: %s\n", hipGetErrorName(le));
}
```
